# Optimizing an MI355X kernel written in HIP

```python
import math
import jax
import jax.numpy as jnp
from jax import lax
import numpy as np

D_MODEL = 1024
BATCH = 16
SEQ = 256
DEPTH = 2
DEC_BATCH = 4
DEC_SEQ = 2048
PAST_LEN = 512

GRID_W = 64
HEAD_DIM = 64
M_HEADS = 4
M_WIDTH = M_HEADS * HEAD_DIM
G_HEADS = 4
G_WIDTH = G_HEADS * HEAD_DIM
CONV_W = 5
A_HEADS = 8
A_KV_HEADS = 2
A_WIDTH = A_HEADS * HEAD_DIM
KV_WIDTH = A_KV_HEADS * HEAD_DIM
MIX_WIDTH = M_WIDTH + G_WIDTH + A_WIDTH
N_DIR = 2
CHUNK = 64
Q_BLOCK = 128
D_FF = 2816
ROPE_BASE = 10000.0
EPS = 1e-6
N_MOD = 9

SPLIT_SIZES = (M_WIDTH, M_WIDTH, M_WIDTH, M_WIDTH, N_DIR * M_HEADS, N_DIR * M_HEADS,
               3 * G_WIDTH, G_WIDTH, N_DIR * G_HEADS, N_DIR * G_HEADS,
               A_WIDTH, KV_WIDTH, KV_WIDTH)
IN_WIDTH = sum(SPLIT_SIZES)

kernel_name = 'hybrid_mlstm_deltanet_gqa_prefix_dit'


def _rms(x, g):
    xf = x.astype(jnp.float32)
    y = xf * lax.rsqrt(jnp.mean(xf * xf, axis=-1, keepdims=True) + EPS)
    return (y * g.astype(jnp.float32)).astype(x.dtype)


def _swiglu(h, w_in, w_out):
    gate, up = jnp.split(h @ w_in, 2, axis=-1)
    return (jax.nn.silu(gate) * up) @ w_out


def _modulation(cond, ada_w, ada_b):
    m = jax.nn.silu(cond) @ ada_w + ada_b
    return m.reshape(m.shape[0], N_MOD, 1, D_MODEL)


def _axial_rope(n):
    rows = n // GRID_W
    row = jnp.repeat(jnp.arange(rows, dtype=jnp.float32), GRID_W)
    col = jnp.tile(jnp.arange(GRID_W, dtype=jnp.float32), rows)
    n_freq = HEAD_DIM // 4
    inv = ROPE_BASE ** (-jnp.arange(n_freq, dtype=jnp.float32) / n_freq)
    ang = jnp.stack([row[:, None] * inv, col[:, None] * inv], axis=1)
    return jnp.cos(ang), jnp.sin(ang)


def _apply_rope(x, cos, sin):
    B, T, H, _ = x.shape
    xf = x.astype(jnp.float32).reshape(B, T, H, 2, 2, HEAD_DIM // 4)
    x1, x2 = xf[..., 0, :], xf[..., 1, :]
    c = cos[None, :, None]
    s = sin[None, :, None]
    out = jnp.stack([x1 * c - x2 * s, x2 * c + x1 * s], axis=-2)
    return out.reshape(x.shape).astype(x.dtype)


def _short_conv(x, w):
    C = x.shape[-1]
    return lax.conv_general_dilated(
        x, w[:, None, :].astype(x.dtype), window_strides=(1,),
        padding=((CONV_W // 2, CONV_W // 2),),
        dimension_numbers=('NWC', 'WIO', 'NWC'), feature_group_count=C)


def _attention(q, k, v):
    B, Sq, H, Dh = q.shape
    kvh = k.shape[2]
    grp = H // kvh
    nb = Sq // Q_BLOCK
    qb = q.reshape(B, nb, Q_BLOCK, kvh, grp, Dh).transpose(1, 0, 2, 3, 4, 5)
    scale = 1.0 / math.sqrt(Dh)

    def block(qblk):
        s = jnp.einsum('bqkgd,bskd->bkgqs', qblk, k).astype(jnp.float32) * scale
        p = jax.nn.softmax(s, axis=-1).astype(v.dtype)
        return jnp.einsum('bkgqs,bskd->bqkgd', p, v)

    o = lax.map(block, qb)
    return o.transpose(1, 0, 2, 3, 4, 5).reshape(B, Sq, H * Dh)


def _mlstm_scan(q, k, v, ig, lf, state):
    B, T, H, Dh = q.shape
    nc = T // CHUNK
    causal = jnp.tril(jnp.ones((CHUNK, CHUNK), bool))[None, :, :, None]

    def chunks(a):
        return jnp.moveaxis(a.reshape(B, nc, CHUNK, *a.shape[2:]), 1, 0)

    def step(carry, xs):
        C, n, m = carry
        qc, kc, vc, ic, fc = xs
        b = jnp.cumsum(fc, axis=1)
        inter = b + m[:, None, :]
        dlog = jnp.where(causal, b[:, :, None, :] - b[:, None, :, :] + ic[:, None, :, :], -jnp.inf)
        mt = jnp.maximum(inter, dlog.max(axis=2))
        s = jnp.einsum('bthd,bjhd->btjh', qc, kc) * jnp.exp(dlog - mt[:, :, None, :])
        a_int = jnp.exp(inter - mt)
        num = jnp.einsum('btjh,bjhe->bthe', s, vc) + a_int[..., None] * jnp.einsum('bthd,bhde->bthe', qc, C)
        den = s.sum(axis=2) + a_int * jnp.einsum('bthd,bhd->bth', qc, n)
        h = num / jnp.maximum(jnp.abs(den), jnp.exp(-mt))[..., None]
        bl = b[:, -1]
        lw = bl[:, None, :] - b + ic
        m_new = jnp.maximum(bl + m, lw.max(axis=1))
        wj = jnp.exp(lw - m_new[:, None, :])
        dec = jnp.exp(bl + m - m_new)
        C = dec[..., None, None] * C + jnp.einsum('bjh,bjhd,bjhe->bhde', wj, kc, vc)
        n = dec[..., None] * n + jnp.einsum('bjh,bjhd->bhd', wj, kc)
        return (C, n, m_new), h

    carry, hs = lax.scan(step, state, (chunks(q), chunks(k), chunks(v), chunks(ig), chunks(lf)))
    return jnp.moveaxis(hs, 0, 1).reshape(B, T, H, Dh), carry


def _delta_scan(q, k, v, g, beta, S0):
    B, T, H, Dh = q.shape
    nc = T // CHUNK

    def chunks(a):
        return jnp.moveaxis(a.reshape(B, nc, CHUNK, H, *a.shape[3:]), 3, 2)

    qc, kc, vc, gc, bc = (chunks(a) for a in (q, k, v, g, beta))
    gcum = jnp.cumsum(gc, axis=-1)
    lower = jnp.tril(jnp.ones((CHUNK, CHUNK), bool))
    strict = jnp.tril(jnp.ones((CHUNK, CHUNK), bool), -1)
    decay = jnp.exp(jnp.where(lower, gcum[..., :, None] - gcum[..., None, :], -jnp.inf))
    kb = kc * bc[..., None]
    a_mat = jnp.eye(CHUNK, dtype=jnp.float32) + jnp.where(
        strict, jnp.einsum('bnhtd,bnhjd->bnhtj', kb, kc) * decay, 0.0)
    u = lax.linalg.triangular_solve(a_mat, vc * bc[..., None], left_side=True, lower=True, unit_diagonal=True)
    w = lax.linalg.triangular_solve(a_mat, kb * jnp.exp(gcum)[..., None], left_side=True, lower=True, unit_diagonal=True)
    qk = jnp.einsum('bnhtd,bnhjd->bnhtj', qc, kc) * decay
    q_dec = qc * jnp.exp(gcum)[..., None]
    k_dec = kc * jnp.exp(gcum[..., -1:] - gcum)[..., None]
    g_last = jnp.exp(gcum[..., -1])

    def step(S, xs):
        qd, kd, uc, wc, qkc, gl = xs
        v_new = uc - jnp.einsum('bhtd,bhde->bhte', wc, S)
        o = jnp.einsum('bhtd,bhde->bhte', qd, S) + jnp.einsum('bhtj,bhje->bhte', qkc, v_new)
        S = S * gl[..., None, None] + jnp.einsum('bhtd,bhte->bhde', kd, v_new)
        return S, o

    xs = tuple(jnp.moveaxis(a, 1, 0) for a in (q_dec, k_dec, u, w, qk, g_last))
    S, o = lax.scan(step, S0, xs)
    o = jnp.moveaxis(jnp.moveaxis(o, 0, 1), 2, 3).reshape(B, T, H, Dh)
    return o, S


def _flip(a):
    return jnp.flip(a, axis=1)


def _mlstm_bidir(q, k, v, ig, lf, C0, n0, m0):
    hf, (Cf, nf, mf) = _mlstm_scan(q, k, v, ig[:, :, 0], lf[:, :, 0], (C0[:, 0], n0[:, 0], m0[:, 0]))
    hb, (Cb, nb, mb) = _mlstm_scan(_flip(q), _flip(k), _flip(v), _flip(ig[:, :, 1]), _flip(lf[:, :, 1]),
                                   (C0[:, 1], n0[:, 1], m0[:, 1]))
    states = (jnp.stack([Cf, Cb], axis=1), jnp.stack([nf, nb], axis=1), jnp.stack([mf, mb], axis=1))
    return hf + _flip(hb), states


def _delta_bidir(q, k, v, g, beta, S0):
    of, Sf = _delta_scan(q, k, v, g[:, :, 0], beta[:, :, 0], S0[:, 0])
    ob, Sb = _delta_scan(_flip(q), _flip(k), _flip(v), _flip(g[:, :, 1]), _flip(beta[:, :, 1]), S0[:, 1])
    return of + _flip(ob), jnp.stack([Sf, Sb], axis=1)


def _mix(h, lw, ctx):
    B, T, _ = h.shape
    f32 = jnp.float32
    z = h @ lw['w_in']
    (mq, mk, mv, mo, mi, mf, gqkv, gz, ga, gb, aq, ak, av) = jnp.split(
        z, np.cumsum(SPLIT_SIZES)[:-1].tolist(), axis=-1)

    def heads(a, n):
        return a.reshape(B, T, n, HEAD_DIM)

    if ctx is None:
        C0 = jnp.zeros((B, N_DIR, M_HEADS, HEAD_DIM, HEAD_DIM), f32)
        n0 = jnp.zeros((B, N_DIR, M_HEADS, HEAD_DIM), f32)
        m0 = jnp.zeros((B, N_DIR, M_HEADS), f32)
        S0 = jnp.zeros((B, N_DIR, G_HEADS, HEAD_DIM, HEAD_DIM), f32)
    else:
        ck, cv, C0, n0, m0, S0 = ctx
        C0, n0, m0, S0 = C0.astype(f32), n0.astype(f32), m0.astype(f32), S0.astype(f32)

    m_q = heads(mq, M_HEADS).astype(f32)
    m_k = heads(mk, M_HEADS).astype(f32) / math.sqrt(HEAD_DIM)
    m_v = heads(mv, M_HEADS).astype(f32)
    ig = mi.reshape(B, T, N_DIR, M_HEADS).astype(f32)
    lf = jax.nn.log_sigmoid(mf.reshape(B, T, N_DIR, M_HEADS).astype(f32) + lw['m_fbias'].astype(f32))
    mh, (Cn, nn_, mn) = _mlstm_bidir(m_q, m_k, m_v, ig, lf, C0, n0, m0)
    m_out = (_rms(mh, lw['m_norm'].reshape(M_HEADS, HEAD_DIM)).reshape(B, T, M_WIDTH)
             * jax.nn.sigmoid(mo.astype(f32))).astype(h.dtype)

    qkv = jax.nn.silu(_short_conv(gqkv, lw['g_conv']))
    gq, gk, gv = jnp.split(qkv, 3, axis=-1)

    def l2(a):
        return a * lax.rsqrt(jnp.sum(a * a, axis=-1, keepdims=True) + EPS)

    d_q = l2(heads(gq, G_HEADS).astype(f32)) / math.sqrt(HEAD_DIM)
    d_k = l2(heads(gk, G_HEADS).astype(f32))
    d_v = heads(gv, G_HEADS).astype(f32)
    g_log = -jnp.exp(lw['g_alog'].astype(f32)) * jax.nn.softplus(
        ga.reshape(B, T, N_DIR, G_HEADS).astype(f32) + lw['g_dtb'].astype(f32))
    beta = jax.nn.sigmoid(gb.reshape(B, T, N_DIR, G_HEADS).astype(f32))
    go, Sn = _delta_bidir(d_q, d_k, d_v, g_log, beta, S0)
    g_out = (_rms(go, lw['g_norm']) * jax.nn.silu(heads(gz, G_HEADS).astype(f32))).reshape(
        B, T, G_WIDTH).astype(h.dtype)

    a_q = _rms(heads(aq, A_HEADS), lw['q_norm'])
    a_k = _rms(heads(ak, A_KV_HEADS), lw['k_norm'])
    a_v = heads(av, A_KV_HEADS)
    if ctx is None:
        keys, vals = a_k, a_v
    else:
        cos, sin = _axial_rope(T)
        a_q = _apply_rope(a_q, cos, sin)
        keys = jnp.concatenate([ck.astype(h.dtype), _apply_rope(a_k, cos, sin)], axis=1)
        vals = jnp.concatenate([cv.astype(h.dtype), a_v], axis=1)
    a_out = _attention(a_q, keys, vals)

    out = jnp.concatenate([m_out, g_out, a_out], axis=-1) @ lw['w_out']
    new_ctx = (a_k, a_v, Cn, nn_, mn, Sn) if ctx is None else None
    return out, new_ctx


def _layer(x, mod, lw, ctx):
    h = _rms(x, lw['norm'][0]) * (1 + mod[:, 0]) + mod[:, 1]
    x = x + 0.5 * mod[:, 2] * _swiglu(h, lw['ffn_in'][0], lw['ffn_out'][0])
    h = _rms(x, lw['norm'][1]) * (1 + mod[:, 3]) + mod[:, 4]
    mix, new_ctx = _mix(h, lw, ctx)
    x = x + mod[:, 5] * mix
    h = _rms(x, lw['norm'][2]) * (1 + mod[:, 6]) + mod[:, 7]
    x = x + 0.5 * mod[:, 8] * _swiglu(h, lw['ffn_in'][1], lw['ffn_out'][1])
    return x, new_ctx


def setup_inputs(seed: int = 0) -> dict:
    key = jax.random.key(seed)
    ks = jax.random.split(key, 26)
    f32 = jnp.float32

    def nrm(k, shape, s=1.0):
        return s * jax.random.normal(k, shape, f32)

    dt = jnp.exp(jax.random.uniform(ks[21], (DEPTH, N_DIR, G_HEADS), f32, math.log(1e-3), math.log(1e-1)))
    return {
        'x_prompt': nrm(ks[0], (BATCH, SEQ, D_MODEL)),
        'x_sample': nrm(ks[1], (DEC_BATCH, DEC_SEQ, D_MODEL)),
        'c': nrm(ks[2], (DEC_BATCH, D_MODEL)),
        'cache_k': nrm(ks[3], (DEC_BATCH, DEPTH, PAST_LEN, A_KV_HEADS, HEAD_DIM)),
        'cache_v': nrm(ks[4], (DEC_BATCH, DEPTH, PAST_LEN, A_KV_HEADS, HEAD_DIM)),
        'state_mlstm_C': nrm(ks[5], (DEC_BATCH, DEPTH, N_DIR, M_HEADS, HEAD_DIM, HEAD_DIM), 0.1),
        'state_mlstm_n': nrm(ks[6], (DEC_BATCH, DEPTH, N_DIR, M_HEADS, HEAD_DIM), 0.1),
        'state_mlstm_m': nrm(ks[7], (DEC_BATCH, DEPTH, N_DIR, M_HEADS)),
        'state_delta_S': nrm(ks[8], (DEC_BATCH, DEPTH, N_DIR, G_HEADS, HEAD_DIM, HEAD_DIM), 0.1),
        'c_ctx': nrm(ks[9], (D_MODEL,)),
        'ada_w': nrm(ks[10], (DEPTH, D_MODEL, N_MOD * D_MODEL), 0.5 * D_MODEL ** -0.5),
        'ada_b': nrm(ks[11], (DEPTH, N_MOD * D_MODEL), 0.01),
        'norm_g': 1.0 + nrm(ks[12], (DEPTH, 3, D_MODEL), 0.02),
        'ffn_w_in': nrm(ks[13], (DEPTH, 2, D_MODEL, 2 * D_FF), D_MODEL ** -0.5),
        'ffn_w_out': nrm(ks[14], (DEPTH, 2, D_FF, D_MODEL), D_FF ** -0.5),
        'w_in': nrm(ks[15], (DEPTH, D_MODEL, IN_WIDTH), D_MODEL ** -0.5),
        'w_out': nrm(ks[16], (DEPTH, MIX_WIDTH, D_MODEL), MIX_WIDTH ** -0.5),
        'mlstm_f_bias': 3.0 + 3.0 * jax.random.uniform(ks[17], (DEPTH, N_DIR, M_HEADS), f32),
        'mlstm_norm': 1.0 + nrm(ks[18], (DEPTH, M_WIDTH), 0.02),
        'delta_conv': nrm(ks[19], (DEPTH, CONV_W, 3 * G_WIDTH), CONV_W ** -0.5),
        'delta_a_log': jnp.log(jax.random.uniform(ks[20], (DEPTH, N_DIR, G_HEADS), f32, 1.0, 16.0)),
        'delta_dt_bias': dt + jnp.log(-jnp.expm1(-dt)),
        'delta_norm': 1.0 + nrm(ks[22], (DEPTH, HEAD_DIM), 0.02),
        'attn_q_norm': 1.0 + nrm(ks[23], (DEPTH, HEAD_DIM), 0.02),
        'attn_k_norm': 1.0 + nrm(ks[24], (DEPTH, HEAD_DIM), 0.02),
        'final_norm': 1.0 + nrm(ks[25], (D_MODEL,), 0.02),
    }


def reference(x_prompt, x_sample, c, cache_k, cache_v, state_mlstm_C, state_mlstm_n,
              state_mlstm_m, state_delta_S, c_ctx, ada_w, ada_b, norm_g, ffn_w_in,
              ffn_w_out, w_in, w_out, mlstm_f_bias, mlstm_norm, delta_conv, delta_a_log,
              delta_dt_bias, delta_norm, attn_q_norm, attn_k_norm, final_norm):
    xp, xs = x_prompt, x_sample
    ks, vs, Cs, ns, ms, Ss = [], [], [], [], [], []
    for l in range(DEPTH):
        lw = {
            'norm': norm_g[l], 'ffn_in': ffn_w_in[l], 'ffn_out': ffn_w_out[l],
            'w_in': w_in[l], 'w_out': w_out[l],
            'm_fbias': mlstm_f_bias[l], 'm_norm': mlstm_norm[l],
            'g_conv': delta_conv[l], 'g_alog': delta_a_log[l], 'g_dtb': delta_dt_bias[l],
            'g_norm': delta_norm[l], 'q_norm': attn_q_norm[l], 'k_norm': attn_k_norm[l],
        }
        xp, (k_l, v_l, C_l, n_l, m_l, S_l) = _layer(xp, _modulation(c_ctx[None, :], ada_w[l], ada_b[l]), lw, None)
        ks.append(k_l)
        vs.append(v_l)
        Cs.append(C_l)
        ns.append(n_l)
        ms.append(m_l)
        Ss.append(S_l)
        ctx = (cache_k[:, l], cache_v[:, l], state_mlstm_C[:, l], state_mlstm_n[:, l],
               state_mlstm_m[:, l], state_delta_S[:, l])
        xs, _ = _layer(xs, _modulation(c, ada_w[l], ada_b[l]), lw, ctx)
    y_prompt = _rms(xp, final_norm)
    y_sample = _rms(xs, final_norm)
    new_k = jnp.stack(ks, axis=1)
    new_v = jnp.stack(vs, axis=1)
    new_C = jnp.stack(Cs, axis=1)
    new_n = jnp.stack(ns, axis=1)
    new_m = jnp.stack(ms, axis=1)
    new_S = jnp.stack(Ss, axis=1)
    return (y_prompt, y_sample, new_k, new_v, new_C, new_n, new_m, new_S)
```

```cpp
#include <hip/hip_runtime.h>
#include <hip/hip_cooperative_groups.h>
#include <stdint.h>
#include <stdio.h>
#include <string.h>
namespace cg = cooperative_groups;

#ifndef MULTI_LAUNCH
#define MULTI_LAUNCH 0
#endif

#define DI __device__ __forceinline__
typedef unsigned short u16;
typedef short s16x8 __attribute__((ext_vector_type(8)));
typedef float f32x16 __attribute__((ext_vector_type(16)));
typedef float f32x4 __attribute__((ext_vector_type(4)));
typedef float f32x2 __attribute__((ext_vector_type(2)));
typedef __bf16 bf16x2_t __attribute__((ext_vector_type(2)));
typedef unsigned u32x2 __attribute__((ext_vector_type(2)));
typedef unsigned u32x4 __attribute__((ext_vector_type(4)));

constexpr int NTOK = 12288, NCTX = 4096, DM = 1024, DFF = 2816, NZ = 2816, NWIN = 2944;
constexpr float EPSF = 1e-6f;
constexpr int NPHASE = 26;
constexpr int SMEM_BYTES = 62464;

constexpr size_t OUT_K = 12582912, OUT_V = 13631488, OUT_C = 14680064, OUT_N = 15728640, OUT_M = 15745024, OUT_S = 15745280;

struct Params {
  const float *xp, *xs, *c, *cache_k, *cache_v, *stC, *stn, *stm, *stS, *c_ctx, *ada_w, *ada_b, *norm_g, *ffn_w_in,
      *ffn_w_out, *w_in, *w_out, *fbias, *mnorm, *dconv, *alog, *dtb, *dnorm, *qnorm, *knorm, *fnorm;
  float* out;
  u16 *wt_ffn_in, *wt_ffn_out, *wt_win, *wt_wout;
  u16* X;
  u16* H;
  u16* R;
  float* Zg;
  float* mod;
  float* rope;
  u16 *KTm, *VTm, *dprep;
  float* dgl;
  u16 *Ubuf, *Cst, *Sst, *Qb, *Kc, *Vc, *Kl, *Vl;
  float *mg_a, *mg_b, *mg_cm, *mchunk, *nUbuf, *nst, *mst;
  unsigned* ctr;
  int lo, hi;
};

DI unsigned pk2(float a, float b) {
  f32x2 v = {a, b};
  return __builtin_bit_cast(unsigned, __builtin_convertvector(v, bf16x2_t));
}
DI float bflo(unsigned u) { return __uint_as_float(u << 16); }
DI float bfhi(unsigned u) { return __uint_as_float(u & 0xffff0000u); }
DI float bf1(u16 v) { return __uint_as_float(((unsigned)v) << 16); }
DI u16 tobf(float x) { return (u16)(pk2(x, x) & 0xffffu); }
DI f32x16 mfma(s16x8 a, s16x8 b, f32x16 c) { return __builtin_amdgcn_mfma_f32_32x32x16_bf16(a, b, c, 0, 0, 0); }
DI int crow(int reg, int h) { return (reg & 3) + 8 * (reg >> 2) + 4 * h; }
DI s16x8 pack8(const f32x16& x, int s) {
  u32x4 p;
  p[0] = pk2(x[8 * s + 0], x[8 * s + 1]);
  p[1] = pk2(x[8 * s + 2], x[8 * s + 3]);
  p[2] = pk2(x[8 * s + 4], x[8 * s + 5]);
  p[3] = pk2(x[8 * s + 6], x[8 * s + 7]);
  return __builtin_bit_cast(s16x8, p);
}
DI s16x8 ldperm(const u16* p, int h) {
  u32x2 lo = *(const u32x2*)(p + 4 * h);
  u32x2 hi = *(const u32x2*)(p + 8 + 4 * h);
  u32x4 r = {lo.x, lo.y, hi.x, hi.y};
  return __builtin_bit_cast(s16x8, r);
}
DI int apos(int row, int k) {
  return (((row >> 5) * 4 + (k >> 4)) * 64 + (((k >> 2) & 1) * 32 + (row & 31))) * 8 + ((k & 3) + 4 * ((k >> 3) & 1));
}
DI f32x16 zero16() {
  f32x16 z;
#pragma unroll
  for (int i = 0; i < 16; ++i) z[i] = 0.f;
  return z;
}
DI float wave_sum(float v) {
#pragma unroll
  for (int o = 32; o >= 1; o >>= 1) v += __shfl_xor(v, o);
  return v;
}
DI int tidx() {
  int t = __builtin_amdgcn_workitem_id_x();
  asm volatile("" : "+v"(t));
  return t;
}
DI unsigned warm_issue(const void* p) {
  unsigned t;
  asm volatile("global_load_dword %0, %1, off" : "=v"(t) : "v"(p) : "memory");
  return t;
}
DI void warm_wait() { asm volatile("s_waitcnt vmcnt(0)" ::: "memory"); }
DI void warm_use(unsigned a) { asm volatile("" ::"v"(a)); }
DI float frcp(float x) { return __builtin_amdgcn_rcpf(x); }
DI float sigmoidf_(float x) { return frcp(1.f + __expf(-x)); }

DI int win_src_col(int n) {
  if (n < 1024) return n;
  if (n < 2048) return n + 16;
  if (n < 2816) return n + 32;
  if (n < 2832) return 1024 + (n - 2816);
  if (n < 2848) return 2064 + (n - 2832);
  return -1;
}
DI int ffnin_src_col(int n) {
  int g = n >> 6, r = n & 63;
  return (r < 32) ? g * 32 + r : 2816 + g * 32 + (r - 32);
}

DI void conv_tile(const float* __restrict__ W, int srcN, u16* __restrict__ Wt, int K, int k0, int n0, int mode, float* tile) {
  const int tid = tidx();
  const int q = tid & 31;
  const int n = n0 + q * 4;
  const int sc = mode == 0 ? n : (mode == 1 ? ffnin_src_col(n) : win_src_col(n));
  f32x4 v[8];
#pragma unroll
  for (int i = 0; i < 8; ++i) {
    const int kk = (tid >> 5) + 8 * i;
    if (sc >= 0) v[i] = __builtin_nontemporal_load((const f32x4*)(W + (size_t)(k0 + kk) * srcN + sc));
    else { v[i].x = 0.f; v[i].y = 0.f; v[i].z = 0.f; v[i].w = 0.f; }
  }
#pragma unroll
  for (int i = 0; i < 8; ++i) {
    const int kk = (tid >> 5) + 8 * i;
    float* t = tile + kk * 129 + q * 4;
    t[0] = v[i].x; t[1] = v[i].y; t[2] = v[i].z; t[3] = v[i].w;
  }
  __syncthreads();
  const int nl = tid & 127, kc0 = tid >> 7;
  const int nn = n0 + nl;
#pragma unroll
  for (int i = 0; i < 4; ++i) {
    const int kch = kc0 + 2 * i;
    const float* tp = tile + (kch * 8) * 129 + nl;
    u32x4 o = {pk2(tp[0], tp[129]), pk2(tp[2 * 129], tp[3 * 129]), pk2(tp[4 * 129], tp[5 * 129]), pk2(tp[6 * 129], tp[7 * 129])};
    const size_t pos = ((size_t)((nn >> 5) * (K >> 4) + (k0 >> 4) + (kch >> 1)) * 64 + (kch & 1) * 32 + (nn & 31)) * 8;
    *(u32x4*)(Wt + pos) = o;
  }
  __syncthreads();
}

DI void ada_item(const Params& P, int item, float* sm) {
  const int tid = tidx();
  const int l = item / 288, n0 = (item % 288) * 32;
  float* ss = sm;
  for (int i = tid; i < 5120; i += 256) {
    int cv = i >> 10, k = i & 1023;
    float x = cv == 0 ? P.c_ctx[k] : P.c[(cv - 1) * 1024 + k];
    ss[i] = x / (1.f + __expf(-x));
  }
  __syncthreads();
  const int c = tid & 31, kg = tid >> 5;
  float acc[5] = {0.f, 0.f, 0.f, 0.f, 0.f};
  const float* w = P.ada_w + (size_t)l * 1024 * 9216 + n0 + c;
#pragma unroll 16
  for (int k = kg * 128; k < kg * 128 + 128; ++k) {
    float wv = w[(size_t)k * 9216];
#pragma unroll
    for (int cv = 0; cv < 5; ++cv) acc[cv] += ss[cv * 1024 + k] * wv;
  }
  float* red = sm + 5120;
#pragma unroll
  for (int cv = 0; cv < 5; ++cv) red[(kg * 5 + cv) * 32 + c] = acc[cv];
  __syncthreads();
  if (tid < 160) {
    int cv = tid >> 5, cc = tid & 31;
    float s = 0.f;
#pragma unroll
    for (int g = 0; g < 8; ++g) s += red[(g * 5 + cv) * 32 + cc];
    P.mod[(size_t)(l * 5 + cv) * 9216 + n0 + cc] = s + P.ada_b[l * 9216 + n0 + cc];
  }
  __syncthreads();
}

constexpr int LAYER_INIT_ITEMS = 288 + 1408 + 704 + 368 + 128;
DI void layer_init_item(const Params& P, int l, int it, float* sm) {
  if (it < 288) { ada_item(P, l * 288 + it, sm); return; }
  it -= 288;
  if (it < 1408) {
    int m = l * 2 + it / 704, rem = it % 704, kt = rem % 16, nt = rem / 16;
    conv_tile(P.ffn_w_in + (size_t)m * 1024 * 5632, 5632, P.wt_ffn_in + (size_t)m * 5632 * 1024, 1024, kt * 64, nt * 128, 1, sm);
    return;
  }
  it -= 1408;
  if (it < 704) {
    int m = l * 2 + it / 352, rem = it % 352, kt = rem % 44, nt = rem / 44;
    conv_tile(P.ffn_w_out + (size_t)m * 2816 * 1024, 1024, P.wt_ffn_out + (size_t)m * 1024 * 2816, 2816, kt * 64, nt * 128, 0, sm);
    return;
  }
  it -= 704;
  if (it < 368) {
    int kt = it % 16, nt = it / 16;
    conv_tile(P.w_in + (size_t)l * 1024 * 2848, 2848, P.wt_win + (size_t)l * NWIN * 1024, 1024, kt * 64, nt * 128, 2, sm);
    return;
  }
  it -= 368;
  {
    int kt = it % 16, nt = it / 16;
    conv_tile(P.w_out + (size_t)l * 1024 * 1024, 1024, P.wt_wout + (size_t)l * 1024 * 1024, 1024, kt * 64, nt * 128, 0, sm);
  }
}

DI void init_phase(const Params& P, char* smem) {
  float* sm = (float*)smem;
  for (int item = blockIdx.x; item < LAYER_INIT_ITEMS + 1; item += gridDim.x) {
    if (item < LAYER_INIT_ITEMS) { layer_init_item(P, 0, item, sm); continue; }
    for (int i = tidx(); i < 1024; i += 256) {
      int pos = i >> 4, f = i & 15;
      float inv = powf(10000.f, -(float)f / 16.f);
      float ang = (float)pos * inv;
      P.rope[i * 2] = cosf(ang);
      P.rope[i * 2 + 1] = sinf(ang);
    }
  }
}

DI void norm_phase_first(const Params& P) {
  const int lane = tidx() & 63;
  const int wave = blockIdx.x * 4 + (tidx() >> 6), nw = gridDim.x * 4;
  const float* g = P.norm_g;
  f32x4 vn[4];
  if (wave < NTOK) {
    const float* s0 = wave < NCTX ? P.xp + (size_t)wave * 1024 : P.xs + (size_t)(wave - NCTX) * 1024;
#pragma unroll
    for (int i = 0; i < 4; ++i) vn[i] = *(const f32x4*)(s0 + i * 256 + lane * 4);
  }
  for (int row = wave; row < NTOK; row += nw) {
    f32x4 v[4];
    float ss = 0.f;
#pragma unroll
    for (int i = 0; i < 4; ++i) {
      v[i] = vn[i];
      ss += v[i].x * v[i].x + v[i].y * v[i].y + v[i].z * v[i].z + v[i].w * v[i].w;
    }
    {
      const int nr = row + nw < NTOK ? row + nw : row;
      const float* s1 = nr < NCTX ? P.xp + (size_t)nr * 1024 : P.xs + (size_t)(nr - NCTX) * 1024;
#pragma unroll
      for (int i = 0; i < 4; ++i) vn[i] = *(const f32x4*)(s1 + i * 256 + lane * 4);
    }
    ss = wave_sum(ss);
    const float rstd = rsqrtf(ss * (1.f / 1024.f) + EPSF);
    const int cv = row < NCTX ? 0 : 1 + ((row - NCTX) >> 11);
    const float* mb = P.mod + (size_t)((0 * 5 + cv) * 9 + 0) * 1024;
#pragma unroll
    for (int i = 0; i < 4; ++i) {
      const int col = i * 256 + lane * 4;
      f32x4 g4 = *(const f32x4*)(g + col);
      f32x4 s4 = *(const f32x4*)(mb + col);
      f32x4 h4 = *(const f32x4*)(mb + 1024 + col);
      float o0 = v[i].x * rstd * g4.x * (1.f + s4.x) + h4.x;
      float o1 = v[i].y * rstd * g4.y * (1.f + s4.y) + h4.y;
      float o2 = v[i].z * rstd * g4.z * (1.f + s4.z) + h4.z;
      float o3 = v[i].w * rstd * g4.w * (1.f + s4.w) + h4.w;
      u32x2 o = {pk2(o0, o1), pk2(o2, o3)};
      *(u32x2*)(P.H + (size_t)row * 1024 + col) = o;
    }
  }
}

struct Row16 { u32x4 a, b; };
DI Row16 ldrow(const u16* X, int row, int lane) {
  Row16 r;
  r.a = *(const u32x4*)(X + (size_t)row * 1024 + lane * 16);
  r.b = *(const u32x4*)(X + (size_t)row * 1024 + lane * 16 + 8);
  return r;
}
DI void unpack16(const Row16& r, float* x) {
  x[0] = bflo(r.a.x); x[1] = bfhi(r.a.x); x[2] = bflo(r.a.y); x[3] = bfhi(r.a.y);
  x[4] = bflo(r.a.z); x[5] = bfhi(r.a.z); x[6] = bflo(r.a.w); x[7] = bfhi(r.a.w);
  x[8] = bflo(r.b.x); x[9] = bfhi(r.b.x); x[10] = bflo(r.b.y); x[11] = bfhi(r.b.y);
  x[12] = bflo(r.b.z); x[13] = bfhi(r.b.z); x[14] = bflo(r.b.w); x[15] = bfhi(r.b.w);
}

DI void norm_phase(const Params& P, int l, int which, bool first) {
  if (first) { norm_phase_first(P); return; }
  const int lane = tidx() & 63;
  const int wave = blockIdx.x * 4 + (tidx() >> 6), nw = gridDim.x * 4;
  const float* g = P.norm_g + (l * 3 + which) * 1024;
  Row16 rn;
  if (wave < NTOK) rn = ldrow(P.X, wave, lane);
  for (int row = wave; row < NTOK; row += nw) {
    float x[16];
    unpack16(rn, x);
    rn = ldrow(P.X, row + nw < NTOK ? row + nw : row, lane);
    float ss = 0.f;
#pragma unroll
    for (int i = 0; i < 16; ++i) ss += x[i] * x[i];
    ss = wave_sum(ss);
    const float rstd = rsqrtf(ss * (1.f / 1024.f) + EPSF);
    const int cv = row < NCTX ? 0 : 1 + ((row - NCTX) >> 11);
    const float* mb = P.mod + (size_t)((l * 5 + cv) * 9 + which * 3) * 1024;
    unsigned ow[8];
#pragma unroll
    for (int q = 0; q < 4; ++q) {
      const int col = lane * 16 + 4 * q;
      f32x4 g4 = *(const f32x4*)(g + col);
      f32x4 s4 = *(const f32x4*)(mb + col);
      f32x4 h4 = *(const f32x4*)(mb + 1024 + col);
      float o0 = x[4 * q + 0] * rstd * g4.x * (1.f + s4.x) + h4.x;
      float o1 = x[4 * q + 1] * rstd * g4.y * (1.f + s4.y) + h4.y;
      float o2 = x[4 * q + 2] * rstd * g4.z * (1.f + s4.z) + h4.z;
      float o3 = x[4 * q + 3] * rstd * g4.w * (1.f + s4.w) + h4.w;
      ow[2 * q] = pk2(o0, o1);
      ow[2 * q + 1] = pk2(o2, o3);
    }
    u32x4 w0 = {ow[0], ow[1], ow[2], ow[3]}, w1 = {ow[4], ow[5], ow[6], ow[7]};
    *(u32x4*)(P.H + (size_t)row * 1024 + lane * 16) = w0;
    *(u32x4*)(P.H + (size_t)row * 1024 + lane * 16 + 8) = w1;
  }
}

DI void final_norm_phase(const Params& P) {
  const int lane = tidx() & 63;
  const int wave = blockIdx.x * 4 + (tidx() >> 6), nw = gridDim.x * 4;
  Row16 rn;
  if (wave < NTOK) rn = ldrow(P.X, wave, lane);
  for (int row = wave; row < NTOK; row += nw) {
    float x[16];
    unpack16(rn, x);
    rn = ldrow(P.X, row + nw < NTOK ? row + nw : row, lane);
    float ss = 0.f;
#pragma unroll
    for (int i = 0; i < 16; ++i) ss += x[i] * x[i];
    ss = wave_sum(ss);
    const float rstd = rsqrtf(ss * (1.f / 1024.f) + EPSF);
#pragma unroll
    for (int q = 0; q < 4; ++q) {
      const int col = lane * 16 + 4 * q;
      f32x4 g4 = *(const f32x4*)(P.fnorm + col);
      f32x4 o = {x[4 * q] * rstd * g4.x, x[4 * q + 1] * rstd * g4.y, x[4 * q + 2] * rstd * g4.z, x[4 * q + 3] * rstd * g4.w};
      *(f32x4*)(P.out + (size_t)row * 1024 + col) = o;
    }
  }
}

template <int EPI, int MI>
DI void gemm_tile(const u16* __restrict__ A, const u16* __restrict__ Bt, int K, int m0, int n0, const Params& P, int l, int midx,
                  float coef, char* smem) {
  constexpr int BM = 64 * MI, NA = 2 * MI;
  char* sA = smem;
  const int tid = tidx(), lane = tid & 63, w = tid >> 6, wm = w & 1, wn = w >> 1, r = lane & 31, h = lane >> 5;
  f32x16 acc[MI][2];
#pragma unroll
  for (int a = 0; a < MI; ++a)
#pragma unroll
    for (int b = 0; b < 2; ++b) acc[a][b] = zero16();
  u32x4 ra[NA];
  s16x8 bq[4][2];
  const int KT = K >> 6;
  const unsigned voff = (unsigned)(((tid >> 3) * K + (tid & 7) * 8) * 2);
  const char* baseA = (const char*)(A + (size_t)m0 * K);
  const size_t rstep = (size_t)32 * K * 2;
  const int woff = (tid >> 3) * 144 + (tid & 7) * 16;
  const char* pa = sA + (wm * 32 * MI + r) * 144 + h * 16;
  const u16* pbq0 = Bt + ((size_t)((n0 + wn * 64) >> 5) * (K >> 4) * 64 + lane) * 8;
  const size_t nistep = (size_t)(K >> 4) * 512;
#pragma unroll
  for (int i = 0; i < NA; ++i) ra[i] = *(const u32x4*)(baseA + i * rstep + voff);
#pragma unroll
  for (int ks = 0; ks < 4; ++ks)
#pragma unroll
    for (int ni = 0; ni < 2; ++ni) bq[ks][ni] = *(const s16x8*)(pbq0 + ni * nistep + (size_t)ks * 512);
#pragma unroll
  for (int i = 0; i < NA; ++i) *(u32x4*)(sA + woff + 32 * i * 144) = ra[i];
  __syncthreads();
  for (int kt = 0; kt < KT; ++kt) {
    const int kn = kt + 1 < KT ? kt + 1 : KT - 1;
    const char* nA = baseA + (size_t)kn * 128;
#pragma unroll
    for (int i = 0; i < NA; ++i) ra[i] = *(const u32x4*)(nA + i * rstep + voff);
    const u16* nb = pbq0 + (size_t)kn * 2048;
    s16x8 afc[MI], afn[MI];
#pragma unroll
    for (int mi = 0; mi < MI; ++mi) afc[mi] = *(const s16x8*)(pa + mi * 32 * 144);
#pragma unroll
    for (int ks = 0; ks < 4; ++ks) {
      if (ks < 3) {
#pragma unroll
        for (int mi = 0; mi < MI; ++mi) afn[mi] = *(const s16x8*)(pa + mi * 32 * 144 + (ks + 1) * 32);
      }
#pragma unroll
      for (int mi = 0; mi < MI; ++mi)
#pragma unroll
        for (int ni = 0; ni < 2; ++ni) acc[mi][ni] = mfma(afc[mi], bq[ks][ni], acc[mi][ni]);
#pragma unroll
      for (int ni = 0; ni < 2; ++ni) bq[ks][ni] = *(const s16x8*)(nb + ni * nistep + (size_t)ks * 512);
      if (ks < 3) {
#pragma unroll
        for (int mi = 0; mi < MI; ++mi) afc[mi] = afn[mi];
      }
    }
    __syncthreads();
#pragma unroll
    for (int i = 0; i < NA; ++i) *(u32x4*)(sA + woff + 32 * i * 144) = ra[i];
    __syncthreads();
  }
  const int rowb = m0 + wm * 32 * MI;
  if (EPI == 1) {
    u16* ACT = P.R;
    const int j = ((n0 + wn * 64) >> 1) + r;
#pragma unroll
    for (int mi = 0; mi < MI; ++mi)
#pragma unroll
      for (int i = 0; i < 16; ++i) {
        int row = rowb + mi * 32 + crow(i, h);
        float g = acc[mi][0][i], u = acc[mi][1][i];
        float a = g * frcp(1.f + __expf(-g)) * u;
        ACT[(size_t)row * DFF + j] = tobf(a);
      }
  } else if (EPI == 2) {
    const bool from_input = (l == 0 && midx == 2);
#pragma unroll
    for (int mi = 0; mi < MI; ++mi) {
      const int R = rowb + mi * 32;
      const int cv = R < NCTX ? 0 : 1 + ((R - NCTX) >> 11);
      const float* mb = P.mod + (size_t)((l * 5 + cv) * 9 + midx) * 1024;
#pragma unroll
      for (int ni = 0; ni < 2; ++ni) {
        const int col = n0 + wn * 64 + ni * 32 + r;
        const float gt = coef * mb[col];
#pragma unroll
        for (int i = 0; i < 16; ++i) {
          int row = R + crow(i, h);
          u16* px = P.X + (size_t)row * 1024 + col;
          const float xo = from_input ? (row < NCTX ? P.xp[(size_t)row * 1024 + col] : P.xs[(size_t)(row - NCTX) * 1024 + col]) : bf1(*px);
          *px = tobf(xo + gt * acc[mi][ni][i]);
        }
      }
    }
  } else {
    u16* Z = P.R;
#pragma unroll
    for (int ni = 0; ni < 2; ++ni) {
      const int cb = n0 + wn * 64 + ni * 32;
      const int col = cb + r;
      if (cb < NZ) {
        const bool is_mv = (cb >= 512 && cb < 768), is_av = (cb >= 2688);
        if (!is_mv && !is_av) {
#pragma unroll
          for (int mi = 0; mi < MI; ++mi)
#pragma unroll
            for (int i = 0; i < 16; ++i) {
              int row = rowb + mi * 32 + crow(i, h);
              Z[(size_t)row * NZ + col] = tobf(acc[mi][ni][i]);
            }
        }
        if (cb >= 256 && cb < 768) {
          u16* T = (cb < 512) ? P.KTm : P.VTm;
          const int cc = (cb < 512) ? col - 256 : col - 512;
          const int hh = cc >> 6, d = cc & 63;
#pragma unroll
          for (int mi = 0; mi < MI; ++mi) {
            const int R = rowb + mi * 32;
            u16* dst = T + ((size_t)((R >> 6) * 4 + hh) * 64 + d) * 64 + (R & 32);
#pragma unroll
            for (int g = 0; g < 4; ++g) {
              u32x2 o = {pk2(acc[mi][ni][4 * g], acc[mi][ni][4 * g + 1]), pk2(acc[mi][ni][4 * g + 2], acc[mi][ni][4 * g + 3])};
              *(u32x2*)(dst + 8 * g + 4 * h) = o;
            }
          }
        } else if (is_av) {
          const int cc = col - 2688, kv = cc >> 6, d = cc & 63;
#pragma unroll
          for (int mi = 0; mi < MI; ++mi) {
            const int R = rowb + mi * 32;
            if (R < NCTX) {
              const int b = R >> 8, t0 = R & 255;
              u16* dst = P.Vc + ((size_t)(b * 2 + kv) * 64 + d) * 256 + t0;
#pragma unroll
              for (int g = 0; g < 4; ++g) {
                u32x2 o = {pk2(acc[mi][ni][4 * g], acc[mi][ni][4 * g + 1]), pk2(acc[mi][ni][4 * g + 2], acc[mi][ni][4 * g + 3])};
                *(u32x2*)(dst + 8 * g + 4 * h) = o;
              }
              float* nv = P.out + OUT_V;
#pragma unroll
              for (int i = 0; i < 16; ++i) {
                int t = t0 + crow(i, h);
                nv[((size_t)((b * 2 + l) * 256 + t) * 2 + kv) * 64 + d] = acc[mi][ni][i];
              }
            } else {
              const int b = (R - NCTX) >> 11, t0 = (R - NCTX) & 2047;
              u16* dst = P.Vl + ((size_t)(b * 2 + kv) * 64 + d) * 2560 + 512 + t0;
#pragma unroll
              for (int g = 0; g < 4; ++g) {
                u32x2 o = {pk2(acc[mi][ni][4 * g], acc[mi][ni][4 * g + 1]), pk2(acc[mi][ni][4 * g + 2], acc[mi][ni][4 * g + 3])};
                *(u32x2*)(dst + 8 * g + 4 * h) = o;
              }
            }
          }
        }
      } else if (cb == NZ) {
#pragma unroll
        for (int mi = 0; mi < MI; ++mi)
#pragma unroll
          for (int i = 0; i < 16; ++i) {
            int row = rowb + mi * 32 + crow(i, h);
            P.Zg[(size_t)row * 32 + r] = acc[mi][ni][i];
          }
      }
    }
  }
}

DI int xcd_tile(int round, int tiles) {
  const int G = gridDim.x, b = blockIdx.x;
  const int base = round * G;
  if (base + G <= tiles && (G & 7) == 0) return base + (b & 7) * (G >> 3) + (b >> 3);
  return base + b;
}
template <int EPI, int MI>
DI void gemm_phase(const u16* A, const u16* Bt, int K, int NT, const Params& P, int l, int midx, float coef, char* smem) {
  constexpr int BM = 64 * MI;
  const int MT = NTOK / BM;
  const int tiles = MT * NT;
  for (int t = blockIdx.x; t < tiles; t += gridDim.x) {
    const int grp = t / (4 * NT), within = t % (4 * NT);
    const int tm = grp * 4 + (within & 3), tn = within >> 2;
    gemm_tile<EPI, MI>(A, Bt, K, tm * BM, tn * 128, P, l, midx, coef, smem);
  }
}

template <int EPI, int MI>
DI void gemm_tile_n4(const u16* __restrict__ A, const u16* __restrict__ Bt, int K, int m0, int n0, const Params& P, int l, int midx,
                     float coef, char* smem) {
  constexpr int BM = 64 * MI, MT = 2 * MI, NA = 2 * MI;
  char* sA = smem;
  const int tid = tidx(), lane = tid & 63, w = tid >> 6, r = lane & 31, h = lane >> 5;
  f32x16 acc[MT];
#pragma unroll
  for (int a = 0; a < MT; ++a) acc[a] = zero16();
  u32x4 ra[NA];
  s16x8 bq[4];
  const int KT = K >> 6;
  const unsigned voff = (unsigned)(((tid >> 3) * K + (tid & 7) * 8) * 2);
  const char* baseA = (const char*)(A + (size_t)m0 * K);
  const size_t rstep = (size_t)32 * K * 2;
  const int woff = (tid >> 3) * 144 + (tid & 7) * 16;
  const char* pa = sA + r * 144 + h * 16;
  const u16* pbq0 = Bt + ((size_t)((n0 >> 5) + w) * (K >> 4) * 64 + lane) * 8;
#pragma unroll
  for (int i = 0; i < NA; ++i) ra[i] = *(const u32x4*)(baseA + i * rstep + voff);
#pragma unroll
  for (int ks = 0; ks < 4; ++ks) bq[ks] = *(const s16x8*)(pbq0 + (size_t)ks * 512);
#pragma unroll
  for (int i = 0; i < NA; ++i) *(u32x4*)(sA + woff + 32 * i * 144) = ra[i];
  __syncthreads();
  for (int kt = 0; kt < KT; ++kt) {
    const int kn = kt + 1 < KT ? kt + 1 : KT - 1;
    const char* nA = baseA + (size_t)kn * 128;
#pragma unroll
    for (int i = 0; i < NA; ++i) ra[i] = *(const u32x4*)(nA + i * rstep + voff);
    const u16* nb = pbq0 + (size_t)kn * 2048;
    s16x8 afc[MT], afn[MT];
#pragma unroll
    for (int mt = 0; mt < MT; ++mt) afc[mt] = *(const s16x8*)(pa + mt * 32 * 144);
#pragma unroll
    for (int ks = 0; ks < 4; ++ks) {
      if (ks < 3) {
#pragma unroll
        for (int mt = 0; mt < MT; ++mt) afn[mt] = *(const s16x8*)(pa + mt * 32 * 144 + (ks + 1) * 32);
      }
#pragma unroll
      for (int mt = 0; mt < MT; ++mt) acc[mt] = mfma(afc[mt], bq[ks], acc[mt]);
      bq[ks] = *(const s16x8*)(nb + (size_t)ks * 512);
      if (ks < 3) {
#pragma unroll
        for (int mt = 0; mt < MT; ++mt) afc[mt] = afn[mt];
      }
    }
    __syncthreads();
#pragma unroll
    for (int i = 0; i < NA; ++i) *(u32x4*)(sA + woff + 32 * i * 144) = ra[i];
    __syncthreads();
  }
  const int cb = n0 + 32 * w;
  const int col = cb + r;
  if (EPI == 2) {
    const bool from_input = (l == 0 && midx == 2);
#pragma unroll
    for (int mt = 0; mt < MT; ++mt) {
      const int R = m0 + mt * 32;
      const int cv = R < NCTX ? 0 : 1 + ((R - NCTX) >> 11);
      const float gt = coef * P.mod[(size_t)((l * 5 + cv) * 9 + midx) * 1024 + col];
#pragma unroll
      for (int i = 0; i < 16; ++i) {
        int row = R + crow(i, h);
        u16* px = P.X + (size_t)row * 1024 + col;
        const float xo = from_input ? (row < NCTX ? P.xp[(size_t)row * 1024 + col] : P.xs[(size_t)(row - NCTX) * 1024 + col]) : bf1(*px);
        *px = tobf(xo + gt * acc[mt][i]);
      }
    }
  } else {
    u16* Z = P.R;
    if (cb < NZ) {
      const bool is_mv = (cb >= 512 && cb < 768), is_av = (cb >= 2688);
      if (!is_mv && !is_av) {
#pragma unroll
        for (int mt = 0; mt < MT; ++mt)
#pragma unroll
          for (int i = 0; i < 16; ++i) {
            int row = m0 + mt * 32 + crow(i, h);
            Z[(size_t)row * NZ + col] = tobf(acc[mt][i]);
          }
      }
      if (cb >= 256 && cb < 768) {
        u16* T = (cb < 512) ? P.KTm : P.VTm;
        const int cc = (cb < 512) ? col - 256 : col - 512;
        const int hh = cc >> 6, d = cc & 63;
#pragma unroll
        for (int mt = 0; mt < MT; ++mt) {
          const int R = m0 + mt * 32;
          u16* dst = T + ((size_t)((R >> 6) * 4 + hh) * 64 + d) * 64 + (R & 32);
#pragma unroll
          for (int g = 0; g < 4; ++g) {
            u32x2 o = {pk2(acc[mt][4 * g], acc[mt][4 * g + 1]), pk2(acc[mt][4 * g + 2], acc[mt][4 * g + 3])};
            *(u32x2*)(dst + 8 * g + 4 * h) = o;
          }
        }
      } else if (is_av) {
        const int cc = col - 2688, kv = cc >> 6, d = cc & 63;
#pragma unroll
        for (int mt = 0; mt < MT; ++mt) {
          const int R = m0 + mt * 32;
          if (R < NCTX) {
            const int b = R >> 8, t0 = R & 255;
            u16* dst = P.Vc + ((size_t)(b * 2 + kv) * 64 + d) * 256 + t0;
#pragma unroll
            for (int g = 0; g < 4; ++g) {
              u32x2 o = {pk2(acc[mt][4 * g], acc[mt][4 * g + 1]), pk2(acc[mt][4 * g + 2], acc[mt][4 * g + 3])};
              *(u32x2*)(dst + 8 * g + 4 * h) = o;
            }
            float* nv = P.out + OUT_V;
#pragma unroll
            for (int i = 0; i < 16; ++i) {
              int t = t0 + crow(i, h);
              nv[((size_t)((b * 2 + l) * 256 + t) * 2 + kv) * 64 + d] = acc[mt][i];
            }
          } else {
            const int b = (R - NCTX) >> 11, t0 = (R - NCTX) & 2047;
            u16* dst = P.Vl + ((size_t)(b * 2 + kv) * 64 + d) * 2560 + 512 + t0;
#pragma unroll
            for (int g = 0; g < 4; ++g) {
              u32x2 o = {pk2(acc[mt][4 * g], acc[mt][4 * g + 1]), pk2(acc[mt][4 * g + 2], acc[mt][4 * g + 3])};
              *(u32x2*)(dst + 8 * g + 4 * h) = o;
            }
          }
        }
      }
    } else if (cb == NZ) {
#pragma unroll
      for (int mt = 0; mt < MT; ++mt)
#pragma unroll
        for (int i = 0; i < 16; ++i) {
          int row = m0 + mt * 32 + crow(i, h);
          P.Zg[(size_t)row * 32 + r] = acc[mt][i];
        }
    }
  }
}

template <int EPI, int MI>
DI void gemm_phase_n4(const u16* A, const u16* Bt, int K, int NT, const Params& P, int l, int midx, float coef, char* smem) {
  constexpr int BM = 64 * MI;
  const int MT_ = NTOK / BM;
  const int tiles = MT_ * NT;
  for (int rd = 0; rd * (int)gridDim.x < tiles; ++rd) {
    const int t = xcd_tile(rd, tiles);
    if (t >= tiles) break;
    const int grp = t / (8 * NT), within = t % (8 * NT);
    const int tm = grp * 8 + (within & 7), tn = within >> 3;
    gemm_tile_n4<EPI, MI>(A, Bt, K, tm * BM, tn * 128, P, l, midx, coef, smem);
  }
}

DI void gemm_tile_e1(const u16* __restrict__ A, const u16* __restrict__ Bt, int K, int m0, int n0, const Params& P, char* smem) {
  constexpr int MT = 4, NA = 4;
  char* sA = smem;
  const int tid = tidx(), lane = tid & 63, w = tid >> 6, r = lane & 31, h = lane >> 5;
  f32x16 acc[MT][2];
#pragma unroll
  for (int a = 0; a < MT; ++a) { acc[a][0] = zero16(); acc[a][1] = zero16(); }
  u32x4 ra[NA];
  s16x8 bq[4][2];
  const int KT = K >> 6;
  const unsigned voff = (unsigned)(((tid >> 3) * K + (tid & 7) * 8) * 2);
  const char* baseA = (const char*)(A + (size_t)m0 * K);
  const size_t rstep = (size_t)32 * K * 2;
  const int woff = (tid >> 3) * 144 + (tid & 7) * 16;
  const char* pa = sA + r * 144 + h * 16;
  const u16* pbq0 = Bt + ((size_t)((n0 >> 5) + 2 * w) * (K >> 4) * 64 + lane) * 8;
  const size_t nistep = (size_t)(K >> 4) * 512;
#pragma unroll
  for (int i = 0; i < NA; ++i) ra[i] = *(const u32x4*)(baseA + i * rstep + voff);
#pragma unroll
  for (int ks = 0; ks < 4; ++ks)
#pragma unroll
    for (int ni = 0; ni < 2; ++ni) bq[ks][ni] = *(const s16x8*)(pbq0 + ni * nistep + (size_t)ks * 512);
#pragma unroll
  for (int i = 0; i < NA; ++i) *(u32x4*)(sA + woff + 32 * i * 144) = ra[i];
  __syncthreads();
  for (int kt = 0; kt < KT; ++kt) {
    const int kn = kt + 1 < KT ? kt + 1 : KT - 1;
    const char* nA = baseA + (size_t)kn * 128;
#pragma unroll
    for (int i = 0; i < NA; ++i) ra[i] = *(const u32x4*)(nA + i * rstep + voff);
    const u16* nb = pbq0 + (size_t)kn * 2048;
    s16x8 afc[MT], afn[MT];
#pragma unroll
    for (int mt = 0; mt < MT; ++mt) afc[mt] = *(const s16x8*)(pa + mt * 32 * 144);
#pragma unroll
    for (int ks = 0; ks < 4; ++ks) {
      if (ks < 3) {
#pragma unroll
        for (int mt = 0; mt < MT; ++mt) afn[mt] = *(const s16x8*)(pa + mt * 32 * 144 + (ks + 1) * 32);
      }
#pragma unroll
      for (int mt = 0; mt < MT; ++mt)
#pragma unroll
        for (int ni = 0; ni < 2; ++ni) acc[mt][ni] = mfma(afc[mt], bq[ks][ni], acc[mt][ni]);
#pragma unroll
      for (int ni = 0; ni < 2; ++ni) bq[ks][ni] = *(const s16x8*)(nb + ni * nistep + (size_t)ks * 512);
      if (ks < 3) {
#pragma unroll
        for (int mt = 0; mt < MT; ++mt) afc[mt] = afn[mt];
      }
    }
    __syncthreads();
#pragma unroll
    for (int i = 0; i < NA; ++i) *(u32x4*)(sA + woff + 32 * i * 144) = ra[i];
    __syncthreads();
  }
  u16* ACT = P.R;
  const int j = ((n0 + w * 64) >> 1) + r;
#pragma unroll
  for (int mt = 0; mt < MT; ++mt)
#pragma unroll
    for (int i = 0; i < 16; ++i) {
      int row = m0 + mt * 32 + crow(i, h);
      float g = acc[mt][0][i], u = acc[mt][1][i];
      float a = g * frcp(1.f + __expf(-g)) * u;
      ACT[(size_t)row * DFF + j] = tobf(a);
    }
}

DI void gemm_phase_e1(const u16* A, const u16* Bt, int K, const Params& P, char* smem) {
  const int NT = 22, MT_ = NTOK / 128;
  const int tiles = MT_ * NT;
  for (int rd = 0; rd * (int)gridDim.x < tiles; ++rd) {
    const int t = xcd_tile(rd, tiles);
    if (t >= tiles) break;
    const int grp = t / (8 * NT), within = t % (8 * NT);
    const int tm = grp * 8 + (within & 7), tn = within >> 3;
    gemm_tile_e1(A, Bt, K, tm * 128, tn * 256, P, smem);
  }
}

DI void attn_prep_tile(const Params& P, int l, int t32) {
  const int lane = tidx() & 63, w = tidx() >> 6;
  const int hl = lane & 31, half = lane >> 5;
  const int d = 2 * hl;
  const u16* Z = P.R;
  const float QSCALE = 0.125f * 1.4426950408889634f;
  const float qn0 = P.qnorm[l * 64 + d], qn1 = P.qnorm[l * 64 + d + 1];
  const float kn0 = P.knorm[l * 64 + d], kn1 = P.knorm[l * 64 + d + 1];
  const int a = hl >> 4, second = (hl >> 3) & 1, f0 = 2 * (hl & 7);
  for (int tt = 0; tt < 8; ++tt) {
    const int token = t32 * 32 + w * 8 + tt;
    unsigned x[5];
#pragma unroll
    for (int i = 0; i < 5; ++i) x[i] = *(const unsigned*)(Z + (size_t)token * NZ + 2048 + (i * 2 + half) * 64 + d);
    const bool ctx = token < NCTX;
    const int p = (token - NCTX) & 2047, b = ctx ? (token >> 8) : ((token - NCTX) >> 11);
    const int pos = a ? (p & 63) : (p >> 6);
    f32x4 cs4 = {1.f, 0.f, 1.f, 0.f};
    if (!ctx) cs4 = *(const f32x4*)(P.rope + (pos * 16 + f0) * 2);
#pragma unroll
    for (int i = 0; i < 5; ++i) {
      const int hh = i * 2 + half;
      const float x0 = bflo(x[i]), x1 = bfhi(x[i]);
      float ss = x0 * x0 + x1 * x1;
#pragma unroll
      for (int o = 16; o >= 1; o >>= 1) ss += __shfl_xor(ss, o);
      const float rstd = rsqrtf(ss * (1.f / 64.f) + EPSF);
      float y0 = x0 * rstd * (hh < 8 ? qn0 : kn0), y1 = x1 * rstd * (hh < 8 ? qn1 : kn1);
      const float p0 = __shfl_xor(y0, 8), p1 = __shfl_xor(y1, 8);
      if (ctx) {
        if (hh < 8) {
          *(unsigned*)(P.Qb + (size_t)token * 512 + hh * 64 + d) = pk2(y0 * QSCALE, y1 * QSCALE);
        } else {
          const int kv = hh - 8, t = token & 255;
          f32x2 o = {y0, y1};
          *(f32x2*)(P.out + OUT_K + ((size_t)((b * 2 + l) * 256 + t) * 2 + kv) * 64 + d) = o;
          *(unsigned*)(P.Kc + ((size_t)(b * 2 + kv) * 256 + t) * 64 + d) = pk2(y0, y1);
        }
      } else {
        const float r0 = second ? (y0 * cs4.x + p0 * cs4.y) : (y0 * cs4.x - p0 * cs4.y);
        const float r1 = second ? (y1 * cs4.z + p1 * cs4.w) : (y1 * cs4.z - p1 * cs4.w);
        if (hh < 8) {
          *(unsigned*)(P.Qb + (size_t)token * 512 + hh * 64 + d) = pk2(r0 * QSCALE, r1 * QSCALE);
        } else {
          const int kv = hh - 8;
          *(unsigned*)(P.Kl + ((size_t)(b * 2 + kv) * 2560 + 512 + p) * 64 + d) = pk2(r0, r1);
        }
      }
    }
  }
}

DI void cache_item(const Params& P, int l, int idx, float* tile) {
  const int tid = tidx();
  const int b = idx >> 4, kv = (idx >> 3) & 1, pos0 = (idx & 7) * 64;
  for (int e = tid; e < 4096; e += 256) {
    int pos = e >> 6, d = e & 63;
    size_t src = ((size_t)((b * 2 + l) * 512 + pos0 + pos) * 2 + kv) * 64 + d;
    P.Kl[((size_t)(b * 2 + kv) * 2560 + pos0 + pos) * 64 + d] = tobf(P.cache_k[src]);
    tile[pos * 65 + d] = P.cache_v[src];
  }
  __syncthreads();
  const int pp = tid & 31;
#pragma unroll
  for (int i = 0; i < 8; ++i) {
    int d = (tid >> 5) + 8 * i;
    unsigned v = pk2(tile[(2 * pp) * 65 + d], tile[(2 * pp + 1) * 65 + d]);
    *(unsigned*)(P.Vl + ((size_t)(b * 2 + kv) * 64 + d) * 2560 + pos0 + 2 * pp) = v;
  }
  __syncthreads();
}

DI void dprep_item(const Params& P, int l, int item, char* smem) {
  const int tid = tidx(), lane = tid & 63, w = tid >> 6, r = lane & 31, h = lane >> 5;
  const int gc = item >> 2, hh = item & 3, r0 = gc * 64;
  int s0, slen;
  if (r0 < NCTX) { s0 = r0 & ~255; slen = 256; } else { s0 = NCTX + ((r0 - NCTX) & ~2047); slen = 2048; }
  u16* sq = (u16*)smem;
  u16* sk = sq + 64 * 72;
  u16* sv = sk + 64 * 72;
  float* Ls = (float*)(smem + 27648);
  float* gcs = (float*)(smem + 27648 + 32768);
  float* bts = gcs + 128;
  float* egs = gcs + 256;
  const u16* Z = P.R;
  const int grp = tid >> 5, cp = tid & 31;
  if (grp < 6) {
    const int which = grp % 3, seg = grp / 3;
    const int chn = which * 256 + hh * 64 + 2 * cp;
    const int zc = 1024 + chn;
    float cw0[5], cw1[5];
#pragma unroll
    for (int wi = 0; wi < 5; ++wi) {
      cw0[wi] = P.dconv[(size_t)(l * 5 + wi) * 768 + chn];
      cw1[wi] = P.dconv[(size_t)(l * 5 + wi) * 768 + chn + 1];
    }
    const int rbase = r0 + seg * 32;
    const int send = s0 + slen;
    unsigned uu[36];
#pragma unroll
    for (int i = 0; i < 36; ++i) {
      const int rr = rbase - 2 + i;
      uu[i] = (rr >= s0 && rr < send) ? *(const unsigned*)(Z + (size_t)rr * NZ + zc) : 0u;
    }
    u16* dst = which == 0 ? sq : (which == 1 ? sk : sv);
#pragma unroll
    for (int t = 0; t < 32; ++t) {
      float y0 = bflo(uu[t]) * cw0[0] + bflo(uu[t + 1]) * cw0[1] + bflo(uu[t + 2]) * cw0[2] + bflo(uu[t + 3]) * cw0[3] + bflo(uu[t + 4]) * cw0[4];
      float y1 = bfhi(uu[t]) * cw1[0] + bfhi(uu[t + 1]) * cw1[1] + bfhi(uu[t + 2]) * cw1[2] + bfhi(uu[t + 3]) * cw1[3] + bfhi(uu[t + 4]) * cw1[4];
      y0 = y0 * frcp(1.f + __expf(-y0));
      y1 = y1 * frcp(1.f + __expf(-y1));
      float ss = y0 * y0 + y1 * y1;
#pragma unroll
      for (int o = 16; o >= 1; o >>= 1) ss += __shfl_xor(ss, o);
      if (which < 2) {
        float rn = rsqrtf(ss + EPSF);
        if (which == 0) rn *= 0.125f;
        y0 *= rn;
        y1 *= rn;
      }
      *(unsigned*)(dst + (seg * 32 + t) * 72 + 2 * cp) = pk2(y0, y1);
    }
  } else {
#pragma unroll
    for (int dir = 0; dir < 2; ++dir) {
      const float graw = P.Zg[(size_t)(r0 + lane) * 32 + 16 + dir * 4 + hh];
      const float braw = P.Zg[(size_t)(r0 + lane) * 32 + 24 + dir * 4 + hh];
      const float Aa = -expf(P.alog[(l * 2 + dir) * 4 + hh]);
      const float x = graw + P.dtb[(l * 2 + dir) * 4 + hh];
      const float sp = x > 20.f ? x : log1pf(expf(x));
      float v = Aa * sp;
      if (dir == 0) {
#pragma unroll
        for (int o = 1; o < 64; o <<= 1) { float t = __shfl_up(v, o); if (lane >= o) v += t; }
      } else {
#pragma unroll
        for (int o = 1; o < 64; o <<= 1) { float t = __shfl_down(v, o); if (lane + o < 64) v += t; }
      }
      const int li = dir ? 63 - lane : lane;
      const float bt = sigmoidf_(braw);
      gcs[dir * 64 + li] = v;
      bts[dir * 64 + li] = bt;
      egs[dir * 64 + li] = bt * __expf(v);
    }
  }
  __syncthreads();
  {
    const int dir = w >> 1, it = w & 1;
    const float* gcd = gcs + dir * 64;
    const float* btd = bts + dir * 64;
    u16* base = P.dprep + (size_t)(item * 2 + dir) * 20480;
    const int ti_a = 32 * it + r;
    const int tr_a = dir ? 63 - ti_a : ti_a;
    s16x8 qa[4], ka[4];
#pragma unroll
    for (int ks = 0; ks < 4; ++ks) {
      qa[ks] = *(const s16x8*)(sq + tr_a * 72 + ks * 16 + h * 8);
      ka[ks] = *(const s16x8*)(sk + tr_a * 72 + ks * 16 + h * 8);
    }
#pragma unroll
    for (int jt = 0; jt < 2; ++jt) {
      const int tj = 32 * jt + r;
      const int tr_b = dir ? 63 - tj : tj;
      f32x16 G = zero16(), QK = zero16();
      if (jt <= it) {
#pragma unroll
        for (int ks = 0; ks < 4; ++ks) {
          s16x8 kb = *(const s16x8*)(sk + tr_b * 72 + ks * 16 + h * 8);
          G = mfma(ka[ks], kb, G);
          QK = mfma(qa[ks], kb, QK);
        }
      }
      const float gj = gcd[tj];
#pragma unroll
      for (int reg = 0; reg < 16; ++reg) {
        const int i = 32 * it + crow(reg, h);
        const float gi = gcd[i], bi = btd[i];
        const float dec = __expf(fminf(gi - gj, 0.f));
        if (jt <= it) Ls[(dir * 64 + i) * 64 + tj] = bi * G[reg] * dec;
        const float qkv = (tj <= i && jt <= it) ? QK[reg] * dec : 0.f;
        base[16384 + apos(i, tj)] = tobf(qkv);
      }
    }
  }
  __syncthreads();
  {
    const int dir = w >> 1, which = w & 1, c = lane;
    const float* Ld = Ls + dir * 4096;
    u16* base = P.dprep + (size_t)(item * 2 + dir) * 20480;
    float x[64];
    const int step = dir ? -72 : 72;
    const u16* pr = (which == 0 ? sv : sk) + (dir ? 63 * 72 : 0) + c;
    const float* scl = (which == 0 ? bts : egs) + dir * 64;
#pragma unroll
    for (int t = 0; t < 64; ++t) {
      float a = bf1(*pr) * scl[t];
      pr += step;
      asm volatile("" : "+v"(pr));
      float a1 = 0.f, a2 = 0.f, a3 = 0.f;
#pragma unroll
      for (int j = 0; j < t; ++j) {
        const float pv = Ld[t * 64 + j] * x[j];
        if ((j & 3) == 0) a -= pv;
        else if ((j & 3) == 1) a1 -= pv;
        else if ((j & 3) == 2) a2 -= pv;
        else a3 -= pv;
      }
      a = (a + a1) + (a2 + a3);
      x[t] = a;
      asm volatile("" ::: "memory");
    }
    if (which == 0) {
      u16* ub = base + ((c >> 5) * 8 * 64 + (c & 31)) * 4;
#pragma unroll
      for (int tt = 0; tt < 2; ++tt)
#pragma unroll
        for (int g = 0; g < 4; ++g)
#pragma unroll
          for (int hp = 0; hp < 2; ++hp) {
            const int t0 = 32 * tt + 8 * g + 4 * hp;
            u32x2 o = {pk2(x[t0], x[t0 + 1]), pk2(x[t0 + 2], x[t0 + 3])};
            *(u32x2*)(ub + ((tt * 4 + g) * 64 + hp * 32) * 4) = o;
          }
    } else {
      u16* wb = base + 4096 + apos(0, c);
#pragma unroll
      for (int t = 0; t < 64; ++t) wb[(t >> 5) * 2048 + (t & 31) * 8] = tobf(x[t]);
    }
  }
#pragma unroll
  for (int dir = 0; dir < 2; ++dir) {
    u16* base = P.dprep + (size_t)(item * 2 + dir) * 20480;
    const float glast = gcs[dir * 64 + 63];
    for (int e = tid; e < 4096; e += 256) {
      const int t = e >> 6, d = e & 63;
      const int tr = dir ? 63 - t : t;
      base[8192 + apos(t, d)] = tobf(bf1(sq[tr * 72 + d]) * __expf(gcs[dir * 64 + t]));
    }
    for (int e = tid; e < 4096; e += 256) {
      const int d = e >> 6, t = e & 63;
      const int tr = dir ? 63 - t : t;
      base[12288 + apos(d, t)] = tobf(bf1(sk[tr * 72 + d]) * __expf(glast - gcs[dir * 64 + t]));
    }
    if (tid == 0) P.dgl[item * 2 + dir] = __expf(glast);
  }
  __syncthreads();
}

DI void mprep_item(const Params& P, int l, int item, float* wsm_all);
DI void prep_phase(const Params& P, int l, char* smem) {
  const int total = 768 + 768 + 384 + 64;
  for (int item = blockIdx.x; item < total; item += gridDim.x) {
    if (item < 768) dprep_item(P, l, item, smem);
    else if (item < 1536) { mprep_item(P, l, item - 768, (float*)smem); __syncthreads(); }
    else if (item < 1920) attn_prep_tile(P, l, item - 1536);
    else cache_item(P, l, item - 1920, (float*)smem);
  }
}

DI void mprep_item(const Params& P, int l, int item, float* wsm_all) {
  const int lane = tidx() & 63, w = tidx() >> 6, r = lane & 31, h = lane >> 5;
  const int dir = w >> 1, et = w & 1;
  const int gc = item >> 2, hh = item & 3, r0 = gc * 64;
  const int cidx = (gc * 4 + hh) * 2 + dir;
  float* wL = wsm_all + w * 64;
  const float fb = P.fbias[(l * 2 + dir) * 4 + hh];
  const int ll = dir ? 0 : 63;
  const float ig = P.Zg[(size_t)(r0 + lane) * 32 + dir * 4 + hh];
  const float fp = P.Zg[(size_t)(r0 + lane) * 32 + 8 + dir * 4 + hh] + fb;
  const float lf = fminf(fp, 0.f) - log1pf(__expf(-fabsf(fp)));
  float bs = lf;
  if (dir == 0) {
#pragma unroll
    for (int o = 1; o < 64; o <<= 1) { float t = __shfl_up(bs, o); if (lane >= o) bs += t; }
  } else {
#pragma unroll
    for (int o = 1; o < 64; o <<= 1) { float t = __shfl_down(bs, o); if (lane + o < 64) bs += t; }
  }
  const float a = ig - bs;
  float cm = a;
  if (dir == 0) {
#pragma unroll
    for (int o = 1; o < 64; o <<= 1) { float t = __shfl_up(cm, o); if (lane >= o) cm = fmaxf(cm, t); }
  } else {
#pragma unroll
    for (int o = 1; o < 64; o <<= 1) { float t = __shfl_down(cm, o); if (lane + o < 64) cm = fmaxf(cm, t); }
  }
  const float bl = __shfl(bs, ll);
  const float cml = __shfl(cm, ll);
  wL[lane] = __expf(a - cml) * 0.125f;
  if (et == 0) {
    const size_t gi = ((size_t)dir * NTOK + r0 + lane) * 4 + hh;
    P.mg_a[gi] = a;
    P.mg_b[gi] = bs;
    P.mg_cm[gi] = cm;
    if (lane == 0) { P.mchunk[cidx * 2] = bl; P.mchunk[cidx * 2 + 1] = cml; }
  }
  __builtin_amdgcn_fence(__ATOMIC_RELEASE, "wavefront");
  __builtin_amdgcn_wave_barrier();
  __builtin_amdgcn_fence(__ATOMIC_ACQUIRE, "wavefront");
  s16x8 Vf[2][2];
  const u16* vt = P.VTm + ((size_t)(gc * 4 + hh) * 64 + 32 * et + r) * 64;
#pragma unroll
  for (int jt = 0; jt < 2; ++jt)
#pragma unroll
    for (int s = 0; s < 2; ++s) Vf[jt][s] = ldperm(vt + 32 * jt + 16 * s, h);
  const u16* kt = P.KTm + ((size_t)(gc * 4 + hh) * 64 + r) * 64;
  u16* dstU = P.Ubuf + (size_t)(cidx * 2 + et) * 2048;
#pragma unroll
  for (int dt = 0; dt < 2; ++dt) {
    f32x16 U = zero16();
    float rs = 0.f;
#pragma unroll
    for (int jt = 0; jt < 2; ++jt)
#pragma unroll
      for (int s = 0; s < 2; ++s) {
        const u16* pk = kt + (32 * dt) * 64 + 32 * jt + 16 * s;
        const u32x2 lo = *(const u32x2*)(pk + 4 * h);
        const u32x2 hi = *(const u32x2*)(pk + 8 + 4 * h);
        const f32x4 w0 = *(const f32x4*)(wL + 32 * jt + 16 * s + 4 * h);
        const f32x4 w1 = *(const f32x4*)(wL + 32 * jt + 16 * s + 8 + 4 * h);
        const float v0 = bflo(lo.x) * w0.x, v1 = bfhi(lo.x) * w0.y, v2 = bflo(lo.y) * w0.z, v3 = bfhi(lo.y) * w0.w;
        const float v4 = bflo(hi.x) * w1.x, v5 = bfhi(hi.x) * w1.y, v6 = bflo(hi.y) * w1.z, v7 = bfhi(hi.y) * w1.w;
        rs += ((v0 + v1) + (v2 + v3)) + ((v4 + v5) + (v6 + v7));
        u32x4 fr = {pk2(v0, v1), pk2(v2, v3), pk2(v4, v5), pk2(v6, v7)};
        U = mfma(__builtin_bit_cast(s16x8, fr), Vf[jt][s], U);
      }
    rs += __shfl_xor(rs, 32);
#pragma unroll
    for (int g = 0; g < 4; ++g) {
      u32x2 o = {pk2(U[4 * g], U[4 * g + 1]), pk2(U[4 * g + 2], U[4 * g + 3])};
      *(u32x2*)(dstU + ((dt * 4 + g) * 64 + lane) * 4) = o;
    }
    if (et == 0 && h == 0) P.nUbuf[cidx * 64 + 32 * dt + r] = rs;
  }
  __builtin_amdgcn_fence(__ATOMIC_RELEASE, "wavefront");
  __builtin_amdgcn_wave_barrier();
}

DI void mstate_item(const Params& P, int l, int seq, int hh) {
  const int lane = tidx() & 63, w = tidx() >> 6, r = lane & 31, h = lane >> 5;
  const int dir = w >> 1, et = w & 1;
  const bool latent = seq >= 16;
  const int nc = latent ? 32 : 4;
  const int gc0 = latent ? 64 + (seq - 16) * 32 : seq * 4;
  const int b = latent ? seq - 16 : seq;
  const int sidx = ((b * 2 + l) * 2 + dir) * 4 + hh;
  f32x16 C[2];
  float nreg = 0.f, m = 0.f;
  C[0] = zero16();
  C[1] = zero16();
  if (latent) {
    const float* sc = P.stC + (size_t)sidx * 4096 + 32 * et + r;
#pragma unroll
    for (int dt = 0; dt < 2; ++dt)
#pragma unroll
      for (int reg = 0; reg < 16; ++reg) C[dt][reg] = sc[(32 * dt + crow(reg, 0) + 4 * h) * 64];
    nreg = P.stn[(size_t)sidx * 64 + lane];
    m = P.stm[sidx];
  }
  u32x2 uA[8], uB[8];
  float nuA, blA, cmlA, nuB = 0.f, blB = 0.f, cmlB = 0.f;
#define MST_LOAD(UU, NU, BL, CML, cc)                                                        \
  {                                                                                          \
    const int gcl_ = gc0 + (dir ? nc - 1 - (cc) : (cc));                                     \
    const int cil_ = (gcl_ * 4 + hh) * 2 + dir;                                              \
    const u16* srcU_ = P.Ubuf + (size_t)(cil_ * 2 + et) * 2048;                              \
    _Pragma("unroll") for (int q = 0; q < 8; ++q) UU[q] = *(const u32x2*)(srcU_ + (q * 64 + lane) * 4); \
    NU = P.nUbuf[cil_ * 64 + lane];                                                          \
    BL = P.mchunk[cil_ * 2];                                                                 \
    CML = P.mchunk[cil_ * 2 + 1];                                                            \
  }
#define MST_STEP(UU, NU, BL, CML, cc)                                                        \
  {                                                                                          \
    const int gcc_ = gc0 + (dir ? nc - 1 - (cc) : (cc));                                     \
    const int cidx_ = (gcc_ * 4 + hh) * 2 + dir;                                             \
    u16* dstC_ = P.Cst + (size_t)(cidx_ * 2 + et) * 2048;                                    \
    _Pragma("unroll") for (int dt = 0; dt < 2; ++dt)                                         \
      _Pragma("unroll") for (int s2 = 0; s2 < 2; ++s2)                                       \
        *(s16x8*)(dstC_ + ((dt * 2 + s2) * 64 + lane) * 8) = pack8(C[dt], s2);               \
    if (et == 0) {                                                                           \
      P.nst[cidx_ * 64 + lane] = nreg;                                                       \
      if (lane == 0) P.mst[cidx_] = m;                                                       \
    }                                                                                        \
    const float Mlast_ = fmaxf(m, CML);                                                      \
    const float dec_ = __expf(m - Mlast_), f_ = __expf(CML - Mlast_);                        \
    _Pragma("unroll") for (int dt = 0; dt < 2; ++dt)                                         \
      _Pragma("unroll") for (int g = 0; g < 4; ++g) {                                        \
        const u32x2 u2 = UU[dt * 4 + g];                                                     \
        C[dt][4 * g + 0] = dec_ * C[dt][4 * g + 0] + f_ * bflo(u2.x);                        \
        C[dt][4 * g + 1] = dec_ * C[dt][4 * g + 1] + f_ * bfhi(u2.x);                        \
        C[dt][4 * g + 2] = dec_ * C[dt][4 * g + 2] + f_ * bflo(u2.y);                        \
        C[dt][4 * g + 3] = dec_ * C[dt][4 * g + 3] + f_ * bfhi(u2.y);                        \
      }                                                                                      \
    nreg = dec_ * nreg + f_ * NU;                                                            \
    m = BL + Mlast_;                                                                         \
  }
  MST_LOAD(uA, nuA, blA, cmlA, 0)
  for (int c = 0; c < nc; c += 2) {
    MST_LOAD(uB, nuB, blB, cmlB, c + 1)
    MST_STEP(uA, nuA, blA, cmlA, c)
    if (c + 2 < nc) MST_LOAD(uA, nuA, blA, cmlA, c + 2)
    MST_STEP(uB, nuB, blB, cmlB, c + 1)
  }
#undef MST_LOAD
#undef MST_STEP
  if (!latent) {
#pragma unroll
    for (int dt = 0; dt < 2; ++dt)
#pragma unroll
      for (int reg = 0; reg < 16; ++reg) {
        const int d = 32 * dt + crow(reg, h), e = 32 * et + r;
        P.out[OUT_C + ((size_t)sidx * 64 + d) * 64 + e] = C[dt][reg];
      }
    if (et == 0) {
      P.out[OUT_N + (size_t)sidx * 64 + lane] = nreg;
      if (lane == 0) P.out[OUT_M + sidx] = m;
    }
  }
}

DI void combine_dirs(const Params& P, int l, int r0, int hh, const float* hbuf, bool is_m) {
  const int tid = tidx();
  const int i = tid >> 2, part = tid & 3, e0 = part * 16;
  const int tok = r0 + i;
  float sv[16];
  float ss = 0.f;
#pragma unroll
  for (int q = 0; q < 4; ++q) {
    const f32x4 x0 = *(const f32x4*)(hbuf + (size_t)(i)*68 + e0 + 4 * q);
    const f32x4 x1 = *(const f32x4*)(hbuf + (size_t)(64 + i) * 68 + e0 + 4 * q);
    sv[4 * q + 0] = x0.x + x1.x; sv[4 * q + 1] = x0.y + x1.y; sv[4 * q + 2] = x0.z + x1.z; sv[4 * q + 3] = x0.w + x1.w;
    ss += sv[4 * q] * sv[4 * q] + sv[4 * q + 1] * sv[4 * q + 1] + sv[4 * q + 2] * sv[4 * q + 2] + sv[4 * q + 3] * sv[4 * q + 3];
  }
  ss += __shfl_xor(ss, 1);
  ss += __shfl_xor(ss, 2);
  const float rstd = rsqrtf(ss * (1.f / 64.f) + EPSF);
  const float* wv = is_m ? P.mnorm + l * 256 + hh * 64 + e0 : P.dnorm + l * 64 + e0;
  const u16* gz = P.R + (size_t)tok * NZ + (is_m ? 768 : 1792) + hh * 64 + e0;
  const u32x4 g0 = *(const u32x4*)(gz), g1 = *(const u32x4*)(gz + 8);
  unsigned gw[8] = {g0.x, g0.y, g0.z, g0.w, g1.x, g1.y, g1.z, g1.w};
  unsigned ow[8];
#pragma unroll
  for (int q = 0; q < 8; ++q) {
    const float ga = bflo(gw[q]), gb = bfhi(gw[q]);
    const float ma = is_m ? sigmoidf_(ga) : ga * sigmoidf_(ga);
    const float mb = is_m ? sigmoidf_(gb) : gb * sigmoidf_(gb);
    ow[q] = pk2(sv[2 * q] * rstd * wv[2 * q] * ma, sv[2 * q + 1] * rstd * wv[2 * q + 1] * mb);
  }
  u16* dst = P.H + (size_t)tok * 1024 + (is_m ? 0 : 256) + hh * 64 + e0;
  u32x4 o0 = {ow[0], ow[1], ow[2], ow[3]}, o1 = {ow[4], ow[5], ow[6], ow[7]};
  *(u32x4*)(dst) = o0;
  *(u32x4*)(dst + 8) = o1;
}

DI void mout_item(const Params& P, int l, int item, char* smem) {
  const int lane = tidx() & 63, w = tidx() >> 6, r = lane & 31, h = lane >> 5;
  const int dir = w >> 1, et = w & 1;
  const int gc = item >> 2, hh = item & 3, r0 = gc * 64;
  const int cidx = (gc * 4 + hh) * 2 + dir;
  float* hbuf = (float*)smem;
  float* aL = (float*)(smem + 34816) + w * 128;
  float* nL = aL + 64;
  const u16* Z = P.R;
  aL[lane] = P.mg_a[((size_t)dir * NTOK + r0 + lane) * 4 + hh];
  nL[lane] = P.nst[cidx * 64 + lane];
  const float m = P.mst[cidx];
  __builtin_amdgcn_fence(__ATOMIC_RELEASE, "wavefront");
  __builtin_amdgcn_wave_barrier();
  __builtin_amdgcn_fence(__ATOMIC_ACQUIRE, "wavefront");
  s16x8 Vf[2][2], Cb[2][2];
  const u16* vt = P.VTm + ((size_t)(gc * 4 + hh) * 64 + 32 * et + r) * 64;
#pragma unroll
  for (int jt = 0; jt < 2; ++jt)
#pragma unroll
    for (int s = 0; s < 2; ++s) Vf[jt][s] = ldperm(vt + 32 * jt + 16 * s, h);
  const u16* srcC = P.Cst + (size_t)(cidx * 2 + et) * 2048;
#pragma unroll
  for (int dt = 0; dt < 2; ++dt)
#pragma unroll
    for (int s = 0; s < 2; ++s) Cb[dt][s] = *(const s16x8*)(srcC + ((dt * 2 + s) * 64 + lane) * 8);
#pragma unroll
  for (int it = 0; it < 2; ++it) {
    const int i = 32 * it + r;
    const size_t gi = ((size_t)dir * NTOK + r0 + i) * 4 + hh;
    const float Mi = fmaxf(m, P.mg_cm[gi]), bi = P.mg_b[gi];
    s16x8 Qf[4];
#pragma unroll
    for (int ks = 0; ks < 4; ++ks) Qf[ks] = ldperm(Z + (size_t)(r0 + i) * NZ + hh * 64 + 16 * ks, h);
    f32x16 NUM = zero16();
    float den = 0.f;
#pragma unroll
    for (int jt = 0; jt < 2; ++jt) {
      f32x16 ST = zero16();
#pragma unroll
      for (int ks = 0; ks < 4; ++ks)
        ST = mfma(ldperm(Z + (size_t)(r0 + 32 * jt + r) * NZ + 256 + hh * 64 + 16 * ks, h), Qf[ks], ST);
#pragma unroll
      for (int reg = 0; reg < 16; ++reg) {
        const int j = 32 * jt + crow(reg, h);
        const bool ok = dir ? (j >= i) : (j <= i);
        const float p = ok ? ST[reg] * 0.125f * __expf(aL[j] - Mi) : 0.f;
        ST[reg] = p;
        den += p;
      }
#pragma unroll
      for (int s = 0; s < 2; ++s) NUM = mfma(Vf[jt][s], pack8(ST, s), NUM);
    }
    f32x16 INT = zero16();
    float qn = 0.f;
#pragma unroll
    for (int dt = 0; dt < 2; ++dt)
#pragma unroll
      for (int s = 0; s < 2; ++s) {
        INT = mfma(Cb[dt][s], Qf[dt * 2 + s], INT);
        const f32x4 n0 = *(const f32x4*)(nL + 32 * dt + 16 * s + 4 * h);
        const f32x4 n1 = *(const f32x4*)(nL + 32 * dt + 16 * s + 8 + 4 * h);
        const u32x4 qq = __builtin_bit_cast(u32x4, Qf[dt * 2 + s]);
        qn += bflo(qq[0]) * n0.x + bfhi(qq[0]) * n0.y + bflo(qq[1]) * n0.z + bfhi(qq[1]) * n0.w;
        qn += bflo(qq[2]) * n1.x + bfhi(qq[2]) * n1.y + bflo(qq[3]) * n1.z + bfhi(qq[3]) * n1.w;
      }
    den += __shfl_xor(den, 32);
    qn += __shfl_xor(qn, 32);
    const float aint = __expf(m - Mi);
    const float dn = den + aint * qn;
    const float mt = bi + Mi;
    const float inv = 1.f / fmaxf(fabsf(dn), __expf(-mt));
    float* hb = hbuf + (size_t)(dir * 64 + i) * 68 + 32 * et + 4 * h;
#pragma unroll
    for (int g = 0; g < 4; ++g) {
      f32x4 o = {(NUM[4 * g + 0] + aint * INT[4 * g + 0]) * inv, (NUM[4 * g + 1] + aint * INT[4 * g + 1]) * inv,
                 (NUM[4 * g + 2] + aint * INT[4 * g + 2]) * inv, (NUM[4 * g + 3] + aint * INT[4 * g + 3]) * inv};
      *(f32x4*)(hb + 8 * g) = o;
    }
  }
  __syncthreads();
  combine_dirs(P, l, r0, hh, hbuf, true);
  __syncthreads();
}

DI void dstate_item(const Params& P, int l, int seq, int hh) {
  const int lane = tidx() & 63, w = tidx() >> 6, r = lane & 31, h = lane >> 5;
  const int dir = w >> 1, et = w & 1;
  const bool latent = seq >= 16;
  const int nc = latent ? 32 : 4;
  const int gc0 = latent ? 64 + (seq - 16) * 32 : seq * 4;
  const int b = latent ? seq - 16 : seq;
  f32x16 S[2];
  S[0] = zero16();
  S[1] = zero16();
  if (latent) {
    const float* sc = P.stS + (size_t)(((b * 2 + l) * 2 + dir) * 4 + hh) * 4096 + 32 * et + r;
#pragma unroll
    for (int dt = 0; dt < 2; ++dt)
#pragma unroll
      for (int reg = 0; reg < 16; ++reg) S[dt][reg] = sc[(32 * dt + crow(reg, 0) + 4 * h) * 64];
  }
  s16x8 WA[2][4], WB[2][4];
  unsigned wmA = 0, wmB = 0, wmC = 0;
#define DST_LOAD(WW, cc)                                                                     \
  {                                                                                          \
    const int gcl_ = gc0 + (dir ? nc - 1 - (cc) : (cc));                                     \
    const int cil_ = (gcl_ * 4 + hh) * 2 + dir;                                              \
    const u16* bl_ = P.dprep + (size_t)cil_ * 20480;                                         \
    _Pragma("unroll") for (int tt = 0; tt < 2; ++tt)                                         \
      _Pragma("unroll") for (int ks = 0; ks < 4; ++ks)                                       \
        WW[tt][ks] = *(const s16x8*)(bl_ + 4096 + ((tt * 4 + ks) * 64 + lane) * 8);         \
      \
    asm volatile("s_waitcnt vmcnt(0)" ::: "memory");                                         \
    warm_use(wmA); warm_use(wmB);                                                            \
    wmA = warm_issue((const char*)bl_ + (size_t)(et * 32 + (lane & 31)) * 128);              \
    wmB = warm_issue((const char*)bl_ + 24576 + (size_t)lane * 128);                         \
  }
#define DST_STEP(WW, cc)                                                                     \
  {                                                                                          \
    const int gcc_ = gc0 + (dir ? nc - 1 - (cc) : (cc));                                     \
    const int cidx_ = (gcc_ * 4 + hh) * 2 + dir;                                             \
    const u16* base_ = P.dprep + (size_t)cidx_ * 20480;                                      \
    const float GL = P.dgl[cidx_];                                                           \
    u32x2 UU[2][4];                                                                          \
    _Pragma("unroll") for (int tt = 0; tt < 2; ++tt)                                         \
      _Pragma("unroll") for (int g = 0; g < 4; ++g)                                          \
        UU[tt][g] = *(const u32x2*)(base_ + (((et * 2 + tt) * 4 + g) * 64 + lane) * 4);      \
    s16x8 Kd[2][4];                                                                          \
    _Pragma("unroll") for (int dt = 0; dt < 2; ++dt)                                         \
      _Pragma("unroll") for (int ks = 0; ks < 4; ++ks)                                       \
        Kd[dt][ks] = *(const s16x8*)(base_ + 12288 + ((dt * 4 + ks) * 64 + lane) * 8);       \
    s16x8 Sb[2][2];                                                                          \
    _Pragma("unroll") for (int dt = 0; dt < 2; ++dt)                                         \
      _Pragma("unroll") for (int s2 = 0; s2 < 2; ++s2) Sb[dt][s2] = pack8(S[dt], s2);        \
    u16* dstS_ = P.Sst + (size_t)(cidx_ * 2 + et) * 2048;                                    \
    _Pragma("unroll") for (int dt = 0; dt < 2; ++dt)                                         \
      _Pragma("unroll") for (int s2 = 0; s2 < 2; ++s2)                                       \
        *(s16x8*)(dstS_ + ((dt * 2 + s2) * 64 + lane) * 8) = Sb[dt][s2];                     \
    s16x8 Vb[2][2];                                                                          \
    _Pragma("unroll") for (int tt = 0; tt < 2; ++tt) {                                       \
      f32x16 WS = zero16();                                                                  \
      _Pragma("unroll") for (int dt = 0; dt < 2; ++dt)                                       \
        _Pragma("unroll") for (int s2 = 0; s2 < 2; ++s2) WS = mfma(WW[tt][dt * 2 + s2], Sb[dt][s2], WS); \
      _Pragma("unroll") for (int g = 0; g < 4; ++g) {                                        \
        const u32x2 u2 = UU[tt][g];                                                          \
        WS[4 * g + 0] = bflo(u2.x) - WS[4 * g + 0];                                          \
        WS[4 * g + 1] = bfhi(u2.x) - WS[4 * g + 1];                                          \
        WS[4 * g + 2] = bflo(u2.y) - WS[4 * g + 2];                                          \
        WS[4 * g + 3] = bfhi(u2.y) - WS[4 * g + 3];                                          \
      }                                                                                      \
      _Pragma("unroll") for (int s2 = 0; s2 < 2; ++s2) Vb[tt][s2] = pack8(WS, s2);           \
    }                                                                                        \
    _Pragma("unroll") for (int dt = 0; dt < 2; ++dt) {                                       \
      _Pragma("unroll") for (int reg = 0; reg < 16; ++reg) S[dt][reg] *= GL;                 \
      _Pragma("unroll") for (int tt = 0; tt < 2; ++tt)                                       \
        _Pragma("unroll") for (int s2 = 0; s2 < 2; ++s2) S[dt] = mfma(Kd[dt][tt * 2 + s2], Vb[tt][s2], S[dt]); \
    }                                                                                        \
  }
  DST_LOAD(WA, 0)
  for (int c = 0; c < nc; c += 2) {
    DST_LOAD(WB, c + 1)
    DST_STEP(WA, c)
    if (c + 2 < nc) DST_LOAD(WA, c + 2)
    DST_STEP(WB, c + 1)
  }
  asm volatile("s_waitcnt vmcnt(0)" ::: "memory");
  warm_use(wmA); warm_use(wmB); warm_use(wmC);
#undef DST_LOAD
#undef DST_STEP
  if (!latent) {
#pragma unroll
    for (int dt = 0; dt < 2; ++dt)
#pragma unroll
      for (int reg = 0; reg < 16; ++reg) {
        const int d = 32 * dt + crow(reg, h), e = 32 * et + r;
        P.out[OUT_S + ((size_t)(((b * 2 + l) * 2 + dir) * 4 + hh) * 64 + d) * 64 + e] = S[dt][reg];
      }
  }
}

DI void dout_item(const Params& P, int l, int item, char* smem) {
  const int lane = tidx() & 63, w = tidx() >> 6, r = lane & 31, h = lane >> 5;
  const int dir = w >> 1, et = w & 1;
  const int gc = item >> 2, hh = item & 3, r0 = gc * 64;
  const int cidx = (gc * 4 + hh) * 2 + dir;
  float* hbuf = (float*)smem;
  const u16* base = P.dprep + (size_t)cidx * 20480;
  s16x8 Sb[2][2];
  const u16* srcS = P.Sst + (size_t)(cidx * 2 + et) * 2048;
#pragma unroll
  for (int dt = 0; dt < 2; ++dt)
#pragma unroll
    for (int s = 0; s < 2; ++s) Sb[dt][s] = *(const s16x8*)(srcS + ((dt * 2 + s) * 64 + lane) * 8);
  s16x8 Vb[2][2];
#pragma unroll
  for (int tt = 0; tt < 2; ++tt) {
    f32x16 WS = zero16();
#pragma unroll
    for (int dt = 0; dt < 2; ++dt)
#pragma unroll
      for (int s = 0; s < 2; ++s)
        WS = mfma(*(const s16x8*)(base + 4096 + ((tt * 4 + dt * 2 + s) * 64 + lane) * 8), Sb[dt][s], WS);
#pragma unroll
    for (int g = 0; g < 4; ++g) {
      u32x2 uu = *(const u32x2*)(base + (((et * 2 + tt) * 4 + g) * 64 + lane) * 4);
      WS[4 * g + 0] = bflo(uu.x) - WS[4 * g + 0];
      WS[4 * g + 1] = bfhi(uu.x) - WS[4 * g + 1];
      WS[4 * g + 2] = bflo(uu.y) - WS[4 * g + 2];
      WS[4 * g + 3] = bfhi(uu.y) - WS[4 * g + 3];
    }
#pragma unroll
    for (int s = 0; s < 2; ++s) Vb[tt][s] = pack8(WS, s);
  }
#pragma unroll
  for (int t2 = 0; t2 < 2; ++t2) {
    f32x16 QS = zero16();
#pragma unroll
    for (int dt = 0; dt < 2; ++dt)
#pragma unroll
      for (int s = 0; s < 2; ++s)
        QS = mfma(*(const s16x8*)(base + 8192 + ((t2 * 4 + dt * 2 + s) * 64 + lane) * 8), Sb[dt][s], QS);
#pragma unroll
    for (int tt = 0; tt <= t2; ++tt)
#pragma unroll
      for (int s = 0; s < 2; ++s)
        QS = mfma(*(const s16x8*)(base + 16384 + ((t2 * 4 + tt * 2 + s) * 64 + lane) * 8), Vb[tt][s], QS);
#pragma unroll
    for (int reg = 0; reg < 16; ++reg) {
      const int t = 32 * t2 + crow(reg, h);
      const int ti = dir ? 63 - t : t;
      hbuf[(size_t)(dir * 64 + ti) * 68 + 32 * et + r] = QS[reg];
    }
  }
  __syncthreads();
  combine_dirs(P, l, r0, hh, hbuf, false);
  __syncthreads();
}

DI void output_phase(const Params& P, int l, char* smem) {
  for (int item = blockIdx.x; item < 1536; item += gridDim.x) {
    if (item < 768) mout_item(P, l, item, smem);
    else dout_item(P, l, item - 768, smem);
  }
}

DI void attn_item(const Params& P, bool latent, int idx, char* smem) {
  const int tid = tidx(), lane = tid & 63, w = tid >> 6, r = lane & 31, h = lane >> 5;
  int b, hq, qt, qrow0, nk, vstride;
  const u16 *Kp, *Vp;
  if (latent) {
    b = idx >> 7; hq = (idx >> 4) & 7; qt = idx & 15;
    qrow0 = NCTX + b * 2048 + qt * 128;
    Kp = P.Kl + (size_t)(b * 2 + (hq >> 2)) * 2560 * 64;
    Vp = P.Vl + (size_t)(b * 2 + (hq >> 2)) * 64 * 2560;
    nk = 2560; vstride = 2560;
  } else {
    b = idx >> 4; hq = (idx >> 1) & 7; qt = idx & 1;
    qrow0 = b * 256 + qt * 128;
    Kp = P.Kc + (size_t)(b * 2 + (hq >> 2)) * 256 * 64;
    Vp = P.Vc + (size_t)(b * 2 + (hq >> 2)) * 64 * 256;
    nk = 256; vstride = 256;
  }
  char* sK = smem;
  char* sV = smem + 64 * 144;
  const int qrow = qrow0 + w * 32 + r;
  s16x8 Qf[4];
#pragma unroll
  for (int ks = 0; ks < 4; ++ks) Qf[ks] = *(const s16x8*)(P.Qb + (size_t)qrow * 512 + hq * 64 + ks * 16 + 8 * h);
  f32x16 O[2];
  O[0] = zero16();
  O[1] = zero16();
  float mrun = -1e30f;
  f32x16 Lacc = zero16();
  const u32x4 ones_u = {0x3F803F80u, 0x3F803F80u, 0x3F803F80u, 0x3F803F80u};
  const s16x8 ones = __builtin_bit_cast(s16x8, ones_u);
  const int NT = nk >> 6;
  const int lrow = tid >> 3, lkc = tid & 7;
  u32x4 rk[2], rv[2];
#pragma unroll
  for (int i = 0; i < 2; ++i) {
    rk[i] = *(const u32x4*)(Kp + (size_t)(lrow + 32 * i) * 64 + lkc * 8);
    rv[i] = *(const u32x4*)(Vp + (size_t)(lrow + 32 * i) * vstride + lkc * 8);
  }
  for (int kt = 0; kt < NT; ++kt) {
#pragma unroll
    for (int i = 0; i < 2; ++i) {
      *(u32x4*)(sK + (lrow + 32 * i) * 144 + lkc * 16) = rk[i];
      *(u32x4*)(sV + (lrow + 32 * i) * 144 + lkc * 16) = rv[i];
    }
    __syncthreads();
    if (kt + 1 < NT) {
#pragma unroll
      for (int i = 0; i < 2; ++i) {
        rk[i] = *(const u32x4*)(Kp + (size_t)((kt + 1) * 64 + lrow + 32 * i) * 64 + lkc * 8);
        rv[i] = *(const u32x4*)(Vp + (size_t)(lrow + 32 * i) * vstride + (kt + 1) * 64 + lkc * 8);
      }
    }
    f32x16 ST[2];
    float mx = -1e30f;
#pragma unroll
    for (int jt = 0; jt < 2; ++jt) {
      ST[jt] = zero16();
#pragma unroll
      for (int ks = 0; ks < 4; ++ks) {
        s16x8 A = *(const s16x8*)(sK + (32 * jt + r) * 144 + ks * 32 + h * 16);
        ST[jt] = mfma(A, Qf[ks], ST[jt]);
      }
#pragma unroll
      for (int reg = 0; reg < 16; ++reg) mx = fmaxf(mx, ST[jt][reg]);
    }
    mx = fmaxf(mx, __shfl_xor(mx, 32));
    const float mnew = fmaxf(mrun, mx);
    const float alpha = __builtin_amdgcn_exp2f(mrun - mnew);
#pragma unroll
    for (int jt = 0; jt < 2; ++jt)
#pragma unroll
      for (int reg = 0; reg < 16; ++reg) ST[jt][reg] = __builtin_amdgcn_exp2f(ST[jt][reg] - mnew);
    const bool grew = mnew > mrun;
    mrun = mnew;
    if (__any(grew)) {
#pragma unroll
      for (int et = 0; et < 2; ++et)
#pragma unroll
        for (int reg = 0; reg < 16; ++reg) O[et][reg] *= alpha;
#pragma unroll
      for (int reg = 0; reg < 16; ++reg) Lacc[reg] *= alpha;
    }
#pragma unroll
    for (int jt = 0; jt < 2; ++jt)
#pragma unroll
      for (int s = 0; s < 2; ++s) {
        s16x8 Bp = pack8(ST[jt], s);
        Lacc = mfma(ones, Bp, Lacc);
#pragma unroll
        for (int et = 0; et < 2; ++et) {
          s16x8 A = ldperm((const u16*)(sV + (32 * et + r) * 144) + 32 * jt + 16 * s, h);
          O[et] = mfma(A, Bp, O[et]);
        }
      }
    __syncthreads();
  }
  const float inv = 1.f / Lacc[0];
  u16* dst = P.H + (size_t)qrow * 1024 + 512 + hq * 64 + 4 * h;
#pragma unroll
  for (int et = 0; et < 2; ++et)
#pragma unroll
    for (int g = 0; g < 4; ++g) {
      u32x2 o = {pk2(O[et][4 * g] * inv, O[et][4 * g + 1] * inv), pk2(O[et][4 * g + 2] * inv, O[et][4 * g + 3] * inv)};
      *(u32x2*)(dst + 32 * et + 8 * g) = o;
    }
}

DI void mixer_phase(const Params& P, int l, char* smem, int cidx) {
  __shared__ int s_item;
  {
    const int b = blockIdx.x;
    if (b < 160) {
      const bool lat = b < 32;
      const int q = lat ? (b & 15) : ((b - 32) & 63);
      const bool is_m = lat ? (b < 16) : (b < 96);
      const int seq = lat ? 16 + (q >> 2) : (q >> 2);
      if (is_m) mstate_item(P, l, seq, q & 3);
      else dstate_item(P, l, seq, q & 3);
    }
  }
  const int total = 768;
  unsigned* ctr = P.ctr + cidx;
  while (true) {
    if (tidx() == 0) s_item = (int)atomicAdd(ctr, 1u);
    __syncthreads();
    const int item = s_item;
    __syncthreads();
    if (item >= total + (l == 0 ? LAYER_INIT_ITEMS : 0)) break;
    if (item >= total) { layer_init_item(P, 1, item - total, (float*)smem); continue; }
    if (item < 512) attn_item(P, true, item, smem);
    else attn_item(P, false, item - 512, smem);
    __syncthreads();
  }
}


#define XB_TMO 128
#define XB_XCNT(j) (256 + 64 * (j))
#define XB_XSUB(j) (1280 + 64 * (j))
#define XB_XGEN(j) (2304 + 64 * (j))
#define XB_TOP 3328
#define XB_TOPGEN 3392
#define XCD_BAR_WORDS 3456
#define XB_SPIN_CAP (1u << 20)
DI unsigned xb_ld(unsigned* p) { return __hip_atomic_load(p, __ATOMIC_RELAXED, __HIP_MEMORY_SCOPE_AGENT); }
DI unsigned xb_add(unsigned* p, unsigned v) { return __hip_atomic_fetch_add(p, v, __ATOMIC_RELAXED, __HIP_MEMORY_SCOPE_AGENT); }
DI unsigned xb_xcc_id() { return (unsigned)__builtin_amdgcn_s_getreg((3 << 11) | 20) & 0xFu; }
#define XB_SPIN(cond, bar)                                                         \
  do {                                                                             \
    unsigned _sp = 0;                                                              \
    while (cond) {                                                                 \
      __builtin_amdgcn_s_sleep(1);                                                 \
      if ((++_sp & 255u) == 0u) {                                                  \
        if (xb_ld(&(bar)[XB_TMO])) break;                                          \
        if (_sp > XB_SPIN_CAP) { atomicAdd(&(bar)[XB_TMO], 1u); break; }           \
      }                                                                            \
    }                                                                              \
  } while (0)

DI void xcd_barrier_complete(unsigned* bar, unsigned x, unsigned& nloc, unsigned& nx) {
  const unsigned G = gridDim.x;
  unsigned sum, cnt, mine, sp = 0u;
  for (;;) {
    sum = 0u; cnt = 0u; mine = 0u;
#pragma unroll
    for (unsigned j = 0; j < 16; ++j) {
      const unsigned c = xb_ld(&bar[XB_XCNT(j)]);
      sum += c;
      cnt += (c > 0u) ? 1u : 0u;
      mine = (j == x) ? c : mine;
    }
    if (sum == G) break;
    __builtin_amdgcn_s_sleep(1);
    if ((++sp & 255u) == 0u) {
      if (xb_ld(&bar[XB_TMO])) break;
      if (sp > XB_SPIN_CAP) { atomicAdd(&bar[XB_TMO], 1u); break; }
    }
  }
  nloc = mine > 0u ? mine : 1u;
  nx = cnt > 0u ? cnt : 1u;
}

DI void xcd_barrier(unsigned* bar, unsigned x, volatile unsigned* st) {
  asm volatile("s_waitcnt vmcnt(0)" ::: "memory");
  __syncthreads();
  if (__builtin_amdgcn_workitem_id_x() == 0) {
    __builtin_amdgcn_s_waitcnt(0);
    unsigned nloc = st[0], nx = st[1];
    if (nloc == 0u) { xcd_barrier_complete(bar, x, nloc, nx); st[0] = nloc; st[1] = nx; }
    const unsigned old = xb_add(&bar[XB_XSUB(x)], 1u);
    const unsigned gen = old / nloc;
    if (old + 1u == (gen + 1u) * nloc) {
      __builtin_amdgcn_fence(__ATOMIC_RELEASE, "agent");
      asm volatile("s_waitcnt vmcnt(0)" ::: "memory");
      const unsigned og = xb_add(&bar[XB_TOP], 1u);
      const unsigned tg = og / nx;
      if (og + 1u == (tg + 1u) * nx) xb_add(&bar[XB_TOPGEN], 1u);
      else XB_SPIN(xb_ld(&bar[XB_TOPGEN]) == tg, bar);
      __builtin_amdgcn_fence(__ATOMIC_ACQUIRE, "agent");
      xb_add(&bar[XB_XGEN(x)], 1u);
      asm volatile("s_waitcnt vmcnt(0)" ::: "memory");
    } else {
      XB_SPIN(xb_ld(&bar[XB_XGEN(x)]) == gen, bar);
      __builtin_amdgcn_fence(__ATOMIC_ACQUIRE, "agent");
      asm volatile("s_waitcnt vmcnt(0)" ::: "memory");
    }
  }
  __syncthreads();
}

DI void run_phase(const Params& P, int ph, char* smem, bool rep = false) {
  if (ph == 0) { init_phase(P, smem); return; }
  if (ph == NPHASE - 1) { final_norm_phase(P); return; }
  const int l = (ph - 1) / 12, s = (ph - 1) % 12;
  switch (s) {
    case 0: norm_phase(P, l, 0, l == 0); break;
    case 1: gemm_phase_e1(P.H, P.wt_ffn_in + (size_t)(l * 2 + 0) * 5632 * 1024, 1024, P, smem); break;
    case 2: gemm_phase_n4<2, 3>(P.R, P.wt_ffn_out + (size_t)(l * 2 + 0) * 1024 * 2816, 2816, 8, P, l, 2, rep ? 0.f : 0.5f, smem); break;
    case 3: norm_phase(P, l, 1, false); break;
    case 4: gemm_phase_n4<3, 3>(P.H, P.wt_win + (size_t)l * NWIN * 1024, 1024, 23, P, l, 0, 0.f, smem); break;
    case 5: prep_phase(P, l, smem); break;
    case 6: mixer_phase(P, l, smem, rep ? 2 + l : l); break;
    case 7: output_phase(P, l, smem); break;
    case 8: gemm_phase_n4<2, 3>(P.H, P.wt_wout + (size_t)l * 1024 * 1024, 1024, 8, P, l, 5, rep ? 0.f : 1.0f, smem); break;
    case 9: norm_phase(P, l, 2, false); break;
    case 10: gemm_phase_e1(P.H, P.wt_ffn_in + (size_t)(l * 2 + 1) * 5632 * 1024, 1024, P, smem); break;
    case 11: gemm_phase_n4<2, 3>(P.R, P.wt_ffn_out + (size_t)(l * 2 + 1) * 1024 * 2816, 2816, 8, P, l, 8, rep ? 0.f : 0.5f, smem); break;
  }
}

__global__ void __launch_bounds__(256, 2) mega_kernel(Params P) {
  __shared__ __attribute__((aligned(16))) char smem[SMEM_BYTES];
  __shared__ __attribute__((aligned(16))) unsigned xb_words[4];
  cg::grid_group grid = cg::this_grid();
  if (P.hi < 0) grid.sync();
  if (__builtin_amdgcn_workitem_id_x() == 0) { xb_words[0] = 0u; xb_words[1] = 0u; xb_words[2] = 0u; xb_words[3] = 0u; }
  __syncthreads();
  const unsigned xcc = xb_xcc_id();
  unsigned* bar = P.ctr + 64;
  if (__builtin_amdgcn_workitem_id_x() == 0) (void)xb_add(&bar[XB_XCNT(xcc)], 1u);
  for (int ph = P.lo; ph < P.hi; ++ph) {
    run_phase(P, ph, smem);
#ifdef PROBE_SET
    {
      const int sI = (ph - 1) % 12;
      bool rp = false;
      if (ph > 0 && ph < NPHASE - 1) {
        if (PROBE_SET == 1) rp = (sI == 1 || sI == 2 || sI == 4 || sI == 8 || sI == 10 || sI == 11);
        if (PROBE_SET == 2) rp = (sI == 5 || sI == 6 || sI == 7);
        if (PROBE_SET == 3) rp = (sI == 0 || sI == 3 || sI == 9);
        if (PROBE_SET == 4) rp = (sI == 5);
        if (PROBE_SET == 5) rp = (sI == 6);
        if (PROBE_SET == 6) rp = (sI == 7);
      }
      if (PROBE_SET == 3 && (ph == 0 || ph == NPHASE - 1)) rp = true;
      if (rp) { xcd_barrier(bar, xcc, xb_words); run_phase(P, ph, smem, true); }
    }
#endif
    if (ph + 1 < P.hi) xcd_barrier(bar, xcc, xb_words);
  }
}

extern "C" void kernel_launch(void* const* d_in, const int* in_sizes, int n_in, void* d_out, int out_size, void* d_ws, size_t ws_size,
                              hipStream_t stream) {
  Params P;
  memset(&P, 0, sizeof(P));
  const float* const* in = (const float* const*)d_in;
  P.xp = in[0]; P.xs = in[1]; P.c = in[2]; P.cache_k = in[3]; P.cache_v = in[4]; P.stC = in[5]; P.stn = in[6]; P.stm = in[7];
  P.stS = in[8]; P.c_ctx = in[9]; P.ada_w = in[10]; P.ada_b = in[11]; P.norm_g = in[12]; P.ffn_w_in = in[13]; P.ffn_w_out = in[14];
  P.w_in = in[15]; P.w_out = in[16]; P.fbias = in[17]; P.mnorm = in[18]; P.dconv = in[19]; P.alog = in[20]; P.dtb = in[21];
  P.dnorm = in[22]; P.qnorm = in[23]; P.knorm = in[24]; P.fnorm = in[25];
  P.out = (float*)d_out;
  char* ws = (char*)d_ws;
  size_t off = 0;
  auto take = [&](size_t bytes) { char* p = ws + off; off += (bytes + 255) & ~(size_t)255; return p; };
  P.ctr = (unsigned*)take(256 + XCD_BAR_WORDS * 4);
  P.wt_ffn_in = (u16*)take((size_t)4 * 5632 * 1024 * 2);
  P.wt_ffn_out = (u16*)take((size_t)4 * 1024 * 2816 * 2);
  P.wt_win = (u16*)take((size_t)2 * NWIN * 1024 * 2);
  P.wt_wout = (u16*)take((size_t)2 * 1024 * 1024 * 2);
  P.X = (u16*)take((size_t)NTOK * 1024 * 2);
  P.H = (u16*)take((size_t)NTOK * 1024 * 2);
  P.R = (u16*)take((size_t)NTOK * 2816 * 2);
  P.Zg = (float*)take((size_t)NTOK * 32 * 4);
  P.mod = (float*)take((size_t)2 * 5 * 9216 * 4);
  P.rope = (float*)take(64 * 16 * 2 * 4);
  P.KTm = (u16*)take((size_t)768 * 4096 * 2);
  P.VTm = (u16*)take((size_t)768 * 4096 * 2);
  P.dprep = (u16*)take((size_t)1536 * 20480 * 2);
  P.dgl = (float*)take(1536 * 4);
  P.Ubuf = (u16*)take((size_t)3072 * 2048 * 2);
  P.Cst = (u16*)take((size_t)3072 * 2048 * 2);
  P.Sst = (u16*)take((size_t)3072 * 2048 * 2);
  P.mg_a = (float*)take((size_t)2 * NTOK * 4 * 4);
  P.mg_b = (float*)take((size_t)2 * NTOK * 4 * 4);
  P.mg_cm = (float*)take((size_t)2 * NTOK * 4 * 4);
  P.mchunk = (float*)take((size_t)1536 * 2 * 4);
  P.nUbuf = (float*)take((size_t)1536 * 64 * 4);
  P.nst = (float*)take((size_t)1536 * 64 * 4);
  P.mst = (float*)take((size_t)1536 * 4);
  P.Qb = (u16*)take((size_t)NTOK * 512 * 2);
  P.Kc = (u16*)take((size_t)16 * 2 * 256 * 64 * 2);
  P.Vc = (u16*)take((size_t)16 * 2 * 256 * 64 * 2);
  P.Kl = (u16*)take((size_t)4 * 2 * 2560 * 64 * 2);
  P.Vl = (u16*)take((size_t)4 * 2 * 2560 * 64 * 2);
  if (off > ws_size) { fprintf(stderr, "workspace too small: need %zu have %zu\n", off, ws_size); return; }

  static int grid_blocks = 0;
  if (!grid_blocks) {
    int dev = 0, cus = 0, per_cu = 0;
    (void)hipGetDevice(&dev);
    (void)hipDeviceGetAttribute(&cus, hipDeviceAttributeMultiprocessorCount, dev);
    (void)hipOccupancyMaxActiveBlocksPerMultiprocessor(&per_cu, mega_kernel, 256, 0);
    if (per_cu > 2) per_cu = 2;
    if (per_cu < 1) per_cu = 1;
    grid_blocks = cus * per_cu;
  }
  (void)hipMemsetAsync(P.ctr, 0, 256 + XCD_BAR_WORDS * 4, stream);
#if MULTI_LAUNCH
  for (int ph = 0; ph < NPHASE; ++ph) {
    P.lo = ph; P.hi = ph + 1;
    hipLaunchKernelGGL(mega_kernel, dim3(grid_blocks), dim3(256), 0, stream, P);
  }
#else
  P.lo = 0; P.hi = NPHASE;
  void* args[] = {&P};
  hipError_t e = hipLaunchCooperativeKernel((void*)mega_kernel, dim3(grid_blocks), dim3(256), args, 0, stream);
  if (e != hipSuccess) fprintf(stderr, "cooperative launch failed: %s (grid %d)\n", hipGetErrorString(e), grid_blocks);
#endif
}
```

```cpp
#include <hip/hip_runtime.h>
#include <hip/hip_cooperative_groups.h>
#include <stdint.h>
#include <stdio.h>
#include <string.h>
namespace cg = cooperative_groups;

#ifndef MULTI_LAUNCH
#define MULTI_LAUNCH 0
#endif

#define DI __device__ __forceinline__
typedef unsigned short u16;
typedef short s16x8 __attribute__((ext_vector_type(8)));
typedef float f32x16 __attribute__((ext_vector_type(16)));
typedef float f32x4 __attribute__((ext_vector_type(4)));
typedef float f32x2 __attribute__((ext_vector_type(2)));
typedef __bf16 bf16x2_t __attribute__((ext_vector_type(2)));
typedef unsigned u32x2 __attribute__((ext_vector_type(2)));
typedef unsigned u32x4 __attribute__((ext_vector_type(4)));

constexpr int NTOK = 12288, NCTX = 4096, DM = 1024, DFF = 2816, NZ = 2816, NWIN = 2944;
constexpr float EPSF = 1e-6f;
constexpr int NPHASE = 26;
constexpr int SMEM_BYTES = 62464;

constexpr size_t OUT_K = 12582912, OUT_V = 13631488, OUT_C = 14680064, OUT_N = 15728640, OUT_M = 15745024, OUT_S = 15745280;

struct Params {
  const float *xp, *xs, *c, *cache_k, *cache_v, *stC, *stn, *stm, *stS, *c_ctx, *ada_w, *ada_b, *norm_g, *ffn_w_in,
      *ffn_w_out, *w_in, *w_out, *fbias, *mnorm, *dconv, *alog, *dtb, *dnorm, *qnorm, *knorm, *fnorm;
  float* out;
  u16 *wt_ffn_in, *wt_ffn_out, *wt_win, *wt_wout;
  u16* X;
  u16* H;
  u16* R;
  float* Zg;
  float* mod;
  float* rope;
  u16 *KTm, *VTm, *dprep;
  float* dgl;
  u16 *Ubuf, *Cst, *Sst, *Qb, *Kc, *Vc, *Kl, *Vl;
  float *mg_a, *mg_b, *mg_cm, *mchunk, *nUbuf, *nst, *mst;
  unsigned* ctr;
  int lo, hi;
};

DI unsigned pk2(float a, float b) {
  f32x2 v = {a, b};
  return __builtin_bit_cast(unsigned, __builtin_convertvector(v, bf16x2_t));
}
DI float bflo(unsigned u) { return __uint_as_float(u << 16); }
DI float bfhi(unsigned u) { return __uint_as_float(u & 0xffff0000u); }
DI float bf1(u16 v) { return __uint_as_float(((unsigned)v) << 16); }
DI u16 tobf(float x) { return (u16)(pk2(x, x) & 0xffffu); }
DI f32x16 mfma(s16x8 a, s16x8 b, f32x16 c) { return __builtin_amdgcn_mfma_f32_32x32x16_bf16(a, b, c, 0, 0, 0); }
DI int crow(int reg, int h) { return (reg & 3) + 8 * (reg >> 2) + 4 * h; }
DI s16x8 pack8(const f32x16& x, int s) {
  u32x4 p;
  p[0] = pk2(x[8 * s + 0], x[8 * s + 1]);
  p[1] = pk2(x[8 * s + 2], x[8 * s + 3]);
  p[2] = pk2(x[8 * s + 4], x[8 * s + 5]);
  p[3] = pk2(x[8 * s + 6], x[8 * s + 7]);
  return __builtin_bit_cast(s16x8, p);
}
DI s16x8 ldperm(const u16* p, int h) {
  u32x2 lo = *(const u32x2*)(p + 4 * h);
  u32x2 hi = *(const u32x2*)(p + 8 + 4 * h);
  u32x4 r = {lo.x, lo.y, hi.x, hi.y};
  return __builtin_bit_cast(s16x8, r);
}
DI int apos(int row, int k) {
  return (((row >> 5) * 4 + (k >> 4)) * 64 + (((k >> 2) & 1) * 32 + (row & 31))) * 8 + ((k & 3) + 4 * ((k >> 3) & 1));
}
DI f32x16 zero16() {
  f32x16 z;
#pragma unroll
  for (int i = 0; i < 16; ++i) z[i] = 0.f;
  return z;
}
DI float wave_sum(float v) {
#pragma unroll
  for (int o = 32; o >= 1; o >>= 1) v += __shfl_xor(v, o);
  return v;
}
DI int tidx() {
  int t = __builtin_amdgcn_workitem_id_x();
  asm volatile("" : "+v"(t));
  return t;
}
DI unsigned warm_issue(const void* p) {
  unsigned t;
  asm volatile("global_load_dword %0, %1, off" : "=v"(t) : "v"(p) : "memory");
  return t;
}
DI void warm_wait() { asm volatile("s_waitcnt vmcnt(0)" ::: "memory"); }
DI void warm_use(unsigned a) { asm volatile("" ::"v"(a)); }
DI float frcp(float x) { return __builtin_amdgcn_rcpf(x); }
DI float sigmoidf_(float x) { return frcp(1.f + __expf(-x)); }

DI int win_src_col(int n) {
  if (n < 1024) return n;
  if (n < 2048) return n + 16;
  if (n < 2816) return n + 32;
  if (n < 2832) return 1024 + (n - 2816);
  if (n < 2848) return 2064 + (n - 2832);
  return -1;
}
DI int ffnin_src_col(int n) {
  int g = n >> 6, r = n & 63;
  return (r < 32) ? g * 32 + r : 2816 + g * 32 + (r - 32);
}

DI void conv_tile(const float* __restrict__ W, int srcN, u16* __restrict__ Wt, int K, int k0, int n0, int mode, float* tile) {
  const int tid = tidx();
  const int q = tid & 31;
  const int n = n0 + q * 4;
  const int sc = mode == 0 ? n : (mode == 1 ? ffnin_src_col(n) : win_src_col(n));
  f32x4 v[8];
#pragma unroll
  for (int i = 0; i < 8; ++i) {
    const int kk = (tid >> 5) + 8 * i;
    if (sc >= 0) v[i] = __builtin_nontemporal_load((const f32x4*)(W + (size_t)(k0 + kk) * srcN + sc));
    else { v[i].x = 0.f; v[i].y = 0.f; v[i].z = 0.f; v[i].w = 0.f; }
  }
#pragma unroll
  for (int i = 0; i < 8; ++i) {
    const int kk = (tid >> 5) + 8 * i;
    float* t = tile + kk * 129 + q * 4;
    t[0] = v[i].x; t[1] = v[i].y; t[2] = v[i].z; t[3] = v[i].w;
  }
  __syncthreads();
  const int nl = tid & 127, kc0 = tid >> 7;
  const int nn = n0 + nl;
#pragma unroll
  for (int i = 0; i < 4; ++i) {
    const int kch = kc0 + 2 * i;
    const float* tp = tile + (kch * 8) * 129 + nl;
    u32x4 o = {pk2(tp[0], tp[129]), pk2(tp[2 * 129], tp[3 * 129]), pk2(tp[4 * 129], tp[5 * 129]), pk2(tp[6 * 129], tp[7 * 129])};
    const size_t pos = ((size_t)((nn >> 5) * (K >> 4) + (k0 >> 4) + (kch >> 1)) * 64 + (kch & 1) * 32 + (nn & 31)) * 8;
    *(u32x4*)(Wt + pos) = o;
  }
  __syncthreads();
}

DI void ada_item(const Params& P, int item, float* sm) {
  const int tid = tidx();
  const int l = item / 288, n0 = (item % 288) * 32;
  float* ss = sm;
  for (int i = tid; i < 5120; i += 256) {
    int cv = i >> 10, k = i & 1023;
    float x = cv == 0 ? P.c_ctx[k] : P.c[(cv - 1) * 1024 + k];
    ss[i] = x / (1.f + __expf(-x));
  }
  __syncthreads();
  const int c = tid & 31, kg = tid >> 5;
  float acc[5] = {0.f, 0.f, 0.f, 0.f, 0.f};
  const float* w = P.ada_w + (size_t)l * 1024 * 9216 + n0 + c;
#pragma unroll 16
  for (int k = kg * 128; k < kg * 128 + 128; ++k) {
    float wv = w[(size_t)k * 9216];
#pragma unroll
    for (int cv = 0; cv < 5; ++cv) acc[cv] += ss[cv * 1024 + k] * wv;
  }
  float* red = sm + 5120;
#pragma unroll
  for (int cv = 0; cv < 5; ++cv) red[(kg * 5 + cv) * 32 + c] = acc[cv];
  __syncthreads();
  if (tid < 160) {
    int cv = tid >> 5, cc = tid & 31;
    float s = 0.f;
#pragma unroll
    for (int g = 0; g < 8; ++g) s += red[(g * 5 + cv) * 32 + cc];
    P.mod[(size_t)(l * 5 + cv) * 9216 + n0 + cc] = s + P.ada_b[l * 9216 + n0 + cc];
  }
  __syncthreads();
}

constexpr int LAYER_INIT_ITEMS = 288 + 1408 + 704 + 368 + 128;
DI void layer_init_item(const Params& P, int l, int it, float* sm) {
  if (it < 288) { ada_item(P, l * 288 + it, sm); return; }
  it -= 288;
  if (it < 1408) {
    int m = l * 2 + it / 704, rem = it % 704, kt = rem % 16, nt = rem / 16;
    conv_tile(P.ffn_w_in + (size_t)m * 1024 * 5632, 5632, P.wt_ffn_in + (size_t)m * 5632 * 1024, 1024, kt * 64, nt * 128, 1, sm);
    return;
  }
  it -= 1408;
  if (it < 704) {
    int m = l * 2 + it / 352, rem = it % 352, kt = rem % 44, nt = rem / 44;
    conv_tile(P.ffn_w_out + (size_t)m * 2816 * 1024, 1024, P.wt_ffn_out + (size_t)m * 1024 * 2816, 2816, kt * 64, nt * 128, 0, sm);
    return;
  }
  it -= 704;
  if (it < 368) {
    int kt = it % 16, nt = it / 16;
    conv_tile(P.w_in + (size_t)l * 1024 * 2848, 2848, P.wt_win + (size_t)l * NWIN * 1024, 1024, kt * 64, nt * 128, 2, sm);
    return;
  }
  it -= 368;
  {
    int kt = it % 16, nt = it / 16;
    conv_tile(P.w_out + (size_t)l * 1024 * 1024, 1024, P.wt_wout + (size_t)l * 1024 * 1024, 1024, kt * 64, nt * 128, 0, sm);
  }
}

DI void init_phase(const Params& P, char* smem) {
  float* sm = (float*)smem;
  for (int item = blockIdx.x; item < LAYER_INIT_ITEMS + 1; item += gridDim.x) {
    if (item < LAYER_INIT_ITEMS) { layer_init_item(P, 0, item, sm); continue; }
    for (int i = tidx(); i < 1024; i += 256) {
      int pos = i >> 4, f = i & 15;
      float inv = powf(10000.f, -(float)f / 16.f);
      float ang = (float)pos * inv;
      P.rope[i * 2] = cosf(ang);
      P.rope[i * 2 + 1] = sinf(ang);
    }
  }
}

DI void norm_phase_first(const Params& P) {
  const int lane = tidx() & 63;
  const int wave = blockIdx.x * 4 + (tidx() >> 6), nw = gridDim.x * 4;
  const float* g = P.norm_g;
  f32x4 vn[4];
  if (wave < NTOK) {
    const float* s0 = wave < NCTX ? P.xp + (size_t)wave * 1024 : P.xs + (size_t)(wave - NCTX) * 1024;
#pragma unroll
    for (int i = 0; i < 4; ++i) vn[i] = *(const f32x4*)(s0 + i * 256 + lane * 4);
  }
  for (int row = wave; row < NTOK; row += nw) {
    f32x4 v[4];
    float ss = 0.f;
#pragma unroll
    for (int i = 0; i < 4; ++i) {
      v[i] = vn[i];
      ss += v[i].x * v[i].x + v[i].y * v[i].y + v[i].z * v[i].z + v[i].w * v[i].w;
    }
    {
      const int nr = row + nw < NTOK ? row + nw : row;
      const float* s1 = nr < NCTX ? P.xp + (size_t)nr * 1024 : P.xs + (size_t)(nr - NCTX) * 1024;
#pragma unroll
      for (int i = 0; i < 4; ++i) vn[i] = *(const f32x4*)(s1 + i * 256 + lane * 4);
    }
    ss = wave_sum(ss);
    const float rstd = rsqrtf(ss * (1.f / 1024.f) + EPSF);
    const int cv = row < NCTX ? 0 : 1 + ((row - NCTX) >> 11);
    const float* mb = P.mod + (size_t)((0 * 5 + cv) * 9 + 0) * 1024;
#pragma unroll
    for (int i = 0; i < 4; ++i) {
      const int col = i * 256 + lane * 4;
      f32x4 g4 = *(const f32x4*)(g + col);
      f32x4 s4 = *(const f32x4*)(mb + col);
      f32x4 h4 = *(const f32x4*)(mb + 1024 + col);
      float o0 = v[i].x * rstd * g4.x * (1.f + s4.x) + h4.x;
      float o1 = v[i].y * rstd * g4.y * (1.f + s4.y) + h4.y;
      float o2 = v[i].z * rstd * g4.z * (1.f + s4.z) + h4.z;
      float o3 = v[i].w * rstd * g4.w * (1.f + s4.w) + h4.w;
      u32x2 o = {pk2(o0, o1), pk2(o2, o3)};
      *(u32x2*)(P.H + (size_t)row * 1024 + col) = o;
    }
  }
}

struct Row16 { u32x4 a, b; };
DI Row16 ldrow(const u16* X, int row, int lane) {
  Row16 r;
  r.a = *(const u32x4*)(X + (size_t)row * 1024 + lane * 16);
  r.b = *(const u32x4*)(X + (size_t)row * 1024 + lane * 16 + 8);
  return r;
}
DI void unpack16(const Row16& r, float* x) {
  x[0] = bflo(r.a.x); x[1] = bfhi(r.a.x); x[2] = bflo(r.a.y); x[3] = bfhi(r.a.y);
  x[4] = bflo(r.a.z); x[5] = bfhi(r.a.z); x[6] = bflo(r.a.w); x[7] = bfhi(r.a.w);
  x[8] = bflo(r.b.x); x[9] = bfhi(r.b.x); x[10] = bflo(r.b.y); x[11] = bfhi(r.b.y);
  x[12] = bflo(r.b.z); x[13] = bfhi(r.b.z); x[14] = bflo(r.b.w); x[15] = bfhi(r.b.w);
}

DI void norm_phase(const Params& P, int l, int which, bool first) {
  if (first) { norm_phase_first(P); return; }
  const int lane = tidx() & 63;
  const int wave = blockIdx.x * 4 + (tidx() >> 6), nw = gridDim.x * 4;
  const float* g = P.norm_g + (l * 3 + which) * 1024;
  Row16 rn;
  if (wave < NTOK) rn = ldrow(P.X, wave, lane);
  for (int row = wave; row < NTOK; row += nw) {
    float x[16];
    unpack16(rn, x);
    rn = ldrow(P.X, row + nw < NTOK ? row + nw : row, lane);
    float ss = 0.f;
#pragma unroll
    for (int i = 0; i < 16; ++i) ss += x[i] * x[i];
    ss = wave_sum(ss);
    const float rstd = rsqrtf(ss * (1.f / 1024.f) + EPSF);
    const int cv = row < NCTX ? 0 : 1 + ((row - NCTX) >> 11);
    const float* mb = P.mod + (size_t)((l * 5 + cv) * 9 + which * 3) * 1024;
    unsigned ow[8];
#pragma unroll
    for (int q = 0; q < 4; ++q) {
      const int col = lane * 16 + 4 * q;
      f32x4 g4 = *(const f32x4*)(g + col);
      f32x4 s4 = *(const f32x4*)(mb + col);
      f32x4 h4 = *(const f32x4*)(mb + 1024 + col);
      float o0 = x[4 * q + 0] * rstd * g4.x * (1.f + s4.x) + h4.x;
      float o1 = x[4 * q + 1] * rstd * g4.y * (1.f + s4.y) + h4.y;
      float o2 = x[4 * q + 2] * rstd * g4.z * (1.f + s4.z) + h4.z;
      float o3 = x[4 * q + 3] * rstd * g4.w * (1.f + s4.w) + h4.w;
      ow[2 * q] = pk2(o0, o1);
      ow[2 * q + 1] = pk2(o2, o3);
    }
    u32x4 w0 = {ow[0], ow[1], ow[2], ow[3]}, w1 = {ow[4], ow[5], ow[6], ow[7]};
    *(u32x4*)(P.H + (size_t)row * 1024 + lane * 16) = w0;
    *(u32x4*)(P.H + (size_t)row * 1024 + lane * 16 + 8) = w1;
  }
}

DI void final_norm_phase(const Params& P) {
  const int lane = tidx() & 63;
  const int wave = blockIdx.x * 4 + (tidx() >> 6), nw = gridDim.x * 4;
  Row16 rn;
  if (wave < NTOK) rn = ldrow(P.X, wave, lane);
  for (int row = wave; row < NTOK; row += nw) {
    float x[16];
    unpack16(rn, x);
    rn = ldrow(P.X, row + nw < NTOK ? row + nw : row, lane);
    float ss = 0.f;
#pragma unroll
    for (int i = 0; i < 16; ++i) ss += x[i] * x[i];
    ss = wave_sum(ss);
    const float rstd = rsqrtf(ss * (1.f / 1024.f) + EPSF);
#pragma unroll
    for (int q = 0; q < 4; ++q) {
      const int col = lane * 16 + 4 * q;
      f32x4 g4 = *(const f32x4*)(P.fnorm + col);
      f32x4 o = {x[4 * q] * rstd * g4.x, x[4 * q + 1] * rstd * g4.y, x[4 * q + 2] * rstd * g4.z, x[4 * q + 3] * rstd * g4.w};
      *(f32x4*)(P.out + (size_t)row * 1024 + col) = o;
    }
  }
}

template <int EPI, int MI>
DI void gemm_tile(const u16* __restrict__ A, const u16* __restrict__ Bt, int K, int m0, int n0, const Params& P, int l, int midx,
                  float coef, char* smem) {
  constexpr int BM = 64 * MI, NA = 2 * MI;
  char* sA = smem;
  const int tid = tidx(), lane = tid & 63, w = tid >> 6, wm = w & 1, wn = w >> 1, r = lane & 31, h = lane >> 5;
  f32x16 acc[MI][2];
#pragma unroll
  for (int a = 0; a < MI; ++a)
#pragma unroll
    for (int b = 0; b < 2; ++b) acc[a][b] = zero16();
  u32x4 ra[NA];
  s16x8 bq[4][2];
  const int KT = K >> 6;
  const unsigned voff = (unsigned)(((tid >> 3) * K + (tid & 7) * 8) * 2);
  const char* baseA = (const char*)(A + (size_t)m0 * K);
  const size_t rstep = (size_t)32 * K * 2;
  const int woff = (tid >> 3) * 144 + (tid & 7) * 16;
  const char* pa = sA + (wm * 32 * MI + r) * 144 + h * 16;
  const u16* pbq0 = Bt + ((size_t)((n0 + wn * 64) >> 5) * (K >> 4) * 64 + lane) * 8;
  const size_t nistep = (size_t)(K >> 4) * 512;
#pragma unroll
  for (int i = 0; i < NA; ++i) ra[i] = *(const u32x4*)(baseA + i * rstep + voff);
#pragma unroll
  for (int ks = 0; ks < 4; ++ks)
#pragma unroll
    for (int ni = 0; ni < 2; ++ni) bq[ks][ni] = *(const s16x8*)(pbq0 + ni * nistep + (size_t)ks * 512);
#pragma unroll
  for (int i = 0; i < NA; ++i) *(u32x4*)(sA + woff + 32 * i * 144) = ra[i];
  __syncthreads();
  for (int kt = 0; kt < KT; ++kt) {
    const int kn = kt + 1 < KT ? kt + 1 : KT - 1;
    const char* nA = baseA + (size_t)kn * 128;
#pragma unroll
    for (int i = 0; i < NA; ++i) ra[i] = *(const u32x4*)(nA + i * rstep + voff);
    const u16* nb = pbq0 + (size_t)kn * 2048;
    s16x8 afc[MI], afn[MI];
#pragma unroll
    for (int mi = 0; mi < MI; ++mi) afc[mi] = *(const s16x8*)(pa + mi * 32 * 144);
#pragma unroll
    for (int ks = 0; ks < 4; ++ks) {
      if (ks < 3) {
#pragma unroll
        for (int mi = 0; mi < MI; ++mi) afn[mi] = *(const s16x8*)(pa + mi * 32 * 144 + (ks + 1) * 32);
      }
#pragma unroll
      for (int mi = 0; mi < MI; ++mi)
#pragma unroll
        for (int ni = 0; ni < 2; ++ni) acc[mi][ni] = mfma(afc[mi], bq[ks][ni], acc[mi][ni]);
#pragma unroll
      for (int ni = 0; ni < 2; ++ni) bq[ks][ni] = *(const s16x8*)(nb + ni * nistep + (size_t)ks * 512);
      if (ks < 3) {
#pragma unroll
        for (int mi = 0; mi < MI; ++mi) afc[mi] = afn[mi];
      }
    }
    __syncthreads();
#pragma unroll
    for (int i = 0; i < NA; ++i) *(u32x4*)(sA + woff + 32 * i * 144) = ra[i];
    __syncthreads();
  }
  const int rowb = m0 + wm * 32 * MI;
  if (EPI == 1) {
    u16* ACT = P.R;
    const int j = ((n0 + wn * 64) >> 1) + r;
#pragma unroll
    for (int mi = 0; mi < MI; ++mi)
#pragma unroll
      for (int i = 0; i < 16; ++i) {
        int row = rowb + mi * 32 + crow(i, h);
        float g = acc[mi][0][i], u = acc[mi][1][i];
        float a = g * frcp(1.f + __expf(-g)) * u;
        ACT[(size_t)row * DFF + j] = tobf(a);
      }
  } else if (EPI == 2) {
    const bool from_input = (l == 0 && midx == 2);
#pragma unroll
    for (int mi = 0; mi < MI; ++mi) {
      const int R = rowb + mi * 32;
      const int cv = R < NCTX ? 0 : 1 + ((R - NCTX) >> 11);
      const float* mb = P.mod + (size_t)((l * 5 + cv) * 9 + midx) * 1024;
#pragma unroll
      for (int ni = 0; ni < 2; ++ni) {
        const int col = n0 + wn * 64 + ni * 32 + r;
        const float gt = coef * mb[col];
#pragma unroll
        for (int i = 0; i < 16; ++i) {
          int row = R + crow(i, h);
          u16* px = P.X + (size_t)row * 1024 + col;
          const float xo = from_input ? (row < NCTX ? P.xp[(size_t)row * 1024 + col] : P.xs[(size_t)(row - NCTX) * 1024 + col]) : bf1(*px);
          *px = tobf(xo + gt * acc[mi][ni][i]);
        }
      }
    }
  } else {
    u16* Z = P.R;
#pragma unroll
    for (int ni = 0; ni < 2; ++ni) {
      const int cb = n0 + wn * 64 + ni * 32;
      const int col = cb + r;
      if (cb < NZ) {
        const bool is_mv = (cb >= 512 && cb < 768), is_av = (cb >= 2688);
        if (!is_mv && !is_av) {
#pragma unroll
          for (int mi = 0; mi < MI; ++mi)
#pragma unroll
            for (int i = 0; i < 16; ++i) {
              int row = rowb + mi * 32 + crow(i, h);
              Z[(size_t)row * NZ + col] = tobf(acc[mi][ni][i]);
            }
        }
        if (cb >= 256 && cb < 768) {
          u16* T = (cb < 512) ? P.KTm : P.VTm;
          const int cc = (cb < 512) ? col - 256 : col - 512;
          const int hh = cc >> 6, d = cc & 63;
#pragma unroll
          for (int mi = 0; mi < MI; ++mi) {
            const int R = rowb + mi * 32;
            u16* dst = T + ((size_t)((R >> 6) * 4 + hh) * 64 + d) * 64 + (R & 32);
#pragma unroll
            for (int g = 0; g < 4; ++g) {
              u32x2 o = {pk2(acc[mi][ni][4 * g], acc[mi][ni][4 * g + 1]), pk2(acc[mi][ni][4 * g + 2], acc[mi][ni][4 * g + 3])};
              *(u32x2*)(dst + 8 * g + 4 * h) = o;
            }
          }
        } else if (is_av) {
          const int cc = col - 2688, kv = cc >> 6, d = cc & 63;
#pragma unroll
          for (int mi = 0; mi < MI; ++mi) {
            const int R = rowb + mi * 32;
            if (R < NCTX) {
              const int b = R >> 8, t0 = R & 255;
              u16* dst = P.Vc + ((size_t)(b * 2 + kv) * 64 + d) * 256 + t0;
#pragma unroll
              for (int g = 0; g < 4; ++g) {
                u32x2 o = {pk2(acc[mi][ni][4 * g], acc[mi][ni][4 * g + 1]), pk2(acc[mi][ni][4 * g + 2], acc[mi][ni][4 * g + 3])};
                *(u32x2*)(dst + 8 * g + 4 * h) = o;
              }
              float* nv = P.out + OUT_V;
#pragma unroll
              for (int i = 0; i < 16; ++i) {
                int t = t0 + crow(i, h);
                nv[((size_t)((b * 2 + l) * 256 + t) * 2 + kv) * 64 + d] = acc[mi][ni][i];
              }
            } else {
              const int b = (R - NCTX) >> 11, t0 = (R - NCTX) & 2047;
              u16* dst = P.Vl + ((size_t)(b * 2 + kv) * 64 + d) * 2560 + 512 + t0;
#pragma unroll
              for (int g = 0; g < 4; ++g) {
                u32x2 o = {pk2(acc[mi][ni][4 * g], acc[mi][ni][4 * g + 1]), pk2(acc[mi][ni][4 * g + 2], acc[mi][ni][4 * g + 3])};
                *(u32x2*)(dst + 8 * g + 4 * h) = o;
              }
            }
          }
        }
      } else if (cb == NZ) {
#pragma unroll
        for (int mi = 0; mi < MI; ++mi)
#pragma unroll
          for (int i = 0; i < 16; ++i) {
            int row = rowb + mi * 32 + crow(i, h);
            P.Zg[(size_t)row * 32 + r] = acc[mi][ni][i];
          }
      }
    }
  }
}

DI int xcd_tile(int round, int tiles) {
  const int G = gridDim.x, b = blockIdx.x;
  const int base = round * G;
  if (base + G <= tiles && (G & 7) == 0) return base + (b & 7) * (G >> 3) + (b >> 3);
  return base + b;
}
template <int EPI, int MI>
DI void gemm_phase(const u16* A, const u16* Bt, int K, int NT, const Params& P, int l, int midx, float coef, char* smem) {
  constexpr int BM = 64 * MI;
  const int MT = NTOK / BM;
  const int tiles = MT * NT;
  for (int t = blockIdx.x; t < tiles; t += gridDim.x) {
    const int grp = t / (4 * NT), within = t % (4 * NT);
    const int tm = grp * 4 + (within & 3), tn = within >> 2;
    gemm_tile<EPI, MI>(A, Bt, K, tm * BM, tn * 128, P, l, midx, coef, smem);
  }
}

template <int EPI, int MI>
DI void gemm_tile_n4(const u16* __restrict__ A, const u16* __restrict__ Bt, int K, int m0, int n0, const Params& P, int l, int midx,
                     float coef, char* smem) {
  constexpr int BM = 64 * MI, MT = 2 * MI, NA = 2 * MI;
  char* sA = smem;
  const int tid = tidx(), lane = tid & 63, w = tid >> 6, r = lane & 31, h = lane >> 5;
  f32x16 acc[MT];
#pragma unroll
  for (int a = 0; a < MT; ++a) acc[a] = zero16();
  u32x4 ra[NA];
  s16x8 bq[4];
  const int KT = K >> 6;
  const unsigned voff = (unsigned)(((tid >> 3) * K + (tid & 7) * 8) * 2);
  const char* baseA = (const char*)(A + (size_t)m0 * K);
  const size_t rstep = (size_t)32 * K * 2;
  const int woff = (tid >> 3) * 144 + (tid & 7) * 16;
  const char* pa = sA + r * 144 + h * 16;
  const u16* pbq0 = Bt + ((size_t)((n0 >> 5) + w) * (K >> 4) * 64 + lane) * 8;
#pragma unroll
  for (int i = 0; i < NA; ++i) ra[i] = *(const u32x4*)(baseA + i * rstep + voff);
#pragma unroll
  for (int ks = 0; ks < 4; ++ks) bq[ks] = *(const s16x8*)(pbq0 + (size_t)ks * 512);
#pragma unroll
  for (int i = 0; i < NA; ++i) *(u32x4*)(sA + woff + 32 * i * 144) = ra[i];
  __syncthreads();
  for (int kt = 0; kt < KT; ++kt) {
    const int kn = kt + 1 < KT ? kt + 1 : KT - 1;
    const char* nA = baseA + (size_t)kn * 128;
#pragma unroll
    for (int i = 0; i < NA; ++i) ra[i] = *(const u32x4*)(nA + i * rstep + voff);
    const u16* nb = pbq0 + (size_t)kn * 2048;
    s16x8 afc[MT], afn[MT];
#pragma unroll
    for (int mt = 0; mt < MT; ++mt) afc[mt] = *(const s16x8*)(pa + mt * 32 * 144);
#pragma unroll
    for (int ks = 0; ks < 4; ++ks) {
      if (ks < 3) {
#pragma unroll
        for (int mt = 0; mt < MT; ++mt) afn[mt] = *(const s16x8*)(pa + mt * 32 * 144 + (ks + 1) * 32);
      }
#pragma unroll
      for (int mt = 0; mt < MT; ++mt) acc[mt] = mfma(afc[mt], bq[ks], acc[mt]);
      bq[ks] = *(const s16x8*)(nb + (size_t)ks * 512);
      if (ks < 3) {
#pragma unroll
        for (int mt = 0; mt < MT; ++mt) afc[mt] = afn[mt];
      }
    }
    __syncthreads();
#pragma unroll
    for (int i = 0; i < NA; ++i) *(u32x4*)(sA + woff + 32 * i * 144) = ra[i];
    __syncthreads();
  }
  const int cb = n0 + 32 * w;
  const int col = cb + r;
  if (EPI == 2) {
    const bool from_input = (l == 0 && midx == 2);
#pragma unroll
    for (int mt = 0; mt < MT; ++mt) {
      const int R = m0 + mt * 32;
      const int cv = R < NCTX ? 0 : 1 + ((R - NCTX) >> 11);
      const float gt = coef * P.mod[(size_t)((l * 5 + cv) * 9 + midx) * 1024 + col];
#pragma unroll
      for (int i = 0; i < 16; ++i) {
        int row = R + crow(i, h);
        u16* px = P.X + (size_t)row * 1024 + col;
        const float xo = from_input ? (row < NCTX ? P.xp[(size_t)row * 1024 + col] : P.xs[(size_t)(row - NCTX) * 1024 + col]) : bf1(*px);
        *px = tobf(xo + gt * acc[mt][i]);
      }
    }
  } else {
    u16* Z = P.R;
    if (cb < NZ) {
      const bool is_mv = (cb >= 512 && cb < 768), is_av = (cb >= 2688);
      if (!is_mv && !is_av) {
#pragma unroll
        for (int mt = 0; mt < MT; ++mt)
#pragma unroll
          for (int i = 0; i < 16; ++i) {
            int row = m0 + mt * 32 + crow(i, h);
            Z[(size_t)row * NZ + col] = tobf(acc[mt][i]);
          }
      }
      if (cb >= 256 && cb < 768) {
        u16* T = (cb < 512) ? P.KTm : P.VTm;
        const int cc = (cb < 512) ? col - 256 : col - 512;
        const int hh = cc >> 6, d = cc & 63;
#pragma unroll
        for (int mt = 0; mt < MT; ++mt) {
          const int R = m0 + mt * 32;
          u16* dst = T + ((size_t)((R >> 6) * 4 + hh) * 64 + d) * 64 + (R & 32);
#pragma unroll
          for (int g = 0; g < 4; ++g) {
            u32x2 o = {pk2(acc[mt][4 * g], acc[mt][4 * g + 1]), pk2(acc[mt][4 * g + 2], acc[mt][4 * g + 3])};
            *(u32x2*)(dst + 8 * g + 4 * h) = o;
          }
        }
      } else if (is_av) {
        const int cc = col - 2688, kv = cc >> 6, d = cc & 63;
#pragma unroll
        for (int mt = 0; mt < MT; ++mt) {
          const int R = m0 + mt * 32;
          if (R < NCTX) {
            const int b = R >> 8, t0 = R & 255;
            u16* dst = P.Vc + ((size_t)(b * 2 + kv) * 64 + d) * 256 + t0;
#pragma unroll
            for (int g = 0; g < 4; ++g) {
              u32x2 o = {pk2(acc[mt][4 * g], acc[mt][4 * g + 1]), pk2(acc[mt][4 * g + 2], acc[mt][4 * g + 3])};
              *(u32x2*)(dst + 8 * g + 4 * h) = o;
            }
            float* nv = P.out + OUT_V;
#pragma unroll
            for (int i = 0; i < 16; ++i) {
              int t = t0 + crow(i, h);
              nv[((size_t)((b * 2 + l) * 256 + t) * 2 + kv) * 64 + d] = acc[mt][i];
            }
          } else {
            const int b = (R - NCTX) >> 11, t0 = (R - NCTX) & 2047;
            u16* dst = P.Vl + ((size_t)(b * 2 + kv) * 64 + d) * 2560 + 512 + t0;
#pragma unroll
            for (int g = 0; g < 4; ++g) {
              u32x2 o = {pk2(acc[mt][4 * g], acc[mt][4 * g + 1]), pk2(acc[mt][4 * g + 2], acc[mt][4 * g + 3])};
              *(u32x2*)(dst + 8 * g + 4 * h) = o;
            }
          }
        }
      }
    } else if (cb == NZ) {
#pragma unroll
      for (int mt = 0; mt < MT; ++mt)
#pragma unroll
        for (int i = 0; i < 16; ++i) {
          int row = m0 + mt * 32 + crow(i, h);
          P.Zg[(size_t)row * 32 + r] = acc[mt][i];
        }
    }
  }
}

template <int EPI, int MI>
DI void gemm_phase_n4(const u16* A, const u16* Bt, int K, int NT, const Params& P, int l, int midx, float coef, char* smem) {
  constexpr int BM = 64 * MI;
  const int MT_ = NTOK / BM;
  const int tiles = MT_ * NT;
  for (int rd = 0; rd * (int)gridDim.x < tiles; ++rd) {
    const int t = xcd_tile(rd, tiles);
    if (t >= tiles) break;
    const int grp = t / (8 * NT), within = t % (8 * NT);
    const int tm = grp * 8 + (within & 7), tn = within >> 3;
    gemm_tile_n4<EPI, MI>(A, Bt, K, tm * BM, tn * 128, P, l, midx, coef, smem);
  }
}

DI void gemm_tile_e1(const u16* __restrict__ A, const u16* __restrict__ Bt, int K, int m0, int n0, const Params& P, char* smem) {
  constexpr int MT = 4, NA = 4;
  char* sA = smem;
  const int tid = tidx(), lane = tid & 63, w = tid >> 6, r = lane & 31, h = lane >> 5;
  f32x16 acc[MT][2];
#pragma unroll
  for (int a = 0; a < MT; ++a) { acc[a][0] = zero16(); acc[a][1] = zero16(); }
  u32x4 ra[NA];
  s16x8 bq[4][2];
  const int KT = K >> 6;
  const unsigned voff = (unsigned)(((tid >> 3) * K + (tid & 7) * 8) * 2);
  const char* baseA = (const char*)(A + (size_t)m0 * K);
  const size_t rstep = (size_t)32 * K * 2;
  const int woff = (tid >> 3) * 144 + (tid & 7) * 16;
  const char* pa = sA + r * 144 + h * 16;
  const u16* pbq0 = Bt + ((size_t)((n0 >> 5) + 2 * w) * (K >> 4) * 64 + lane) * 8;
  const size_t nistep = (size_t)(K >> 4) * 512;
#pragma unroll
  for (int i = 0; i < NA; ++i) ra[i] = *(const u32x4*)(baseA + i * rstep + voff);
#pragma unroll
  for (int ks = 0; ks < 4; ++ks)
#pragma unroll
    for (int ni = 0; ni < 2; ++ni) bq[ks][ni] = *(const s16x8*)(pbq0 + ni * nistep + (size_t)ks * 512);
#pragma unroll
  for (int i = 0; i < NA; ++i) *(u32x4*)(sA + woff + 32 * i * 144) = ra[i];
  __syncthreads();
  for (int kt = 0; kt < KT; ++kt) {
    const int kn = kt + 1 < KT ? kt + 1 : KT - 1;
    const char* nA = baseA + (size_t)kn * 128;
#pragma unroll
    for (int i = 0; i < NA; ++i) ra[i] = *(const u32x4*)(nA + i * rstep + voff);
    const u16* nb = pbq0 + (size_t)kn * 2048;
    s16x8 afc[MT], afn[MT];
#pragma unroll
    for (int mt = 0; mt < MT; ++mt) afc[mt] = *(const s16x8*)(pa + mt * 32 * 144);
#pragma unroll
    for (int ks = 0; ks < 4; ++ks) {
      if (ks < 3) {
#pragma unroll
        for (int mt = 0; mt < MT; ++mt) afn[mt] = *(const s16x8*)(pa + mt * 32 * 144 + (ks + 1) * 32);
      }
#pragma unroll
      for (int mt = 0; mt < MT; ++mt)
#pragma unroll
        for (int ni = 0; ni < 2; ++ni) acc[mt][ni] = mfma(afc[mt], bq[ks][ni], acc[mt][ni]);
#pragma unroll
      for (int ni = 0; ni < 2; ++ni) bq[ks][ni] = *(const s16x8*)(nb + ni * nistep + (size_t)ks * 512);
      if (ks < 3) {
#pragma unroll
        for (int mt = 0; mt < MT; ++mt) afc[mt] = afn[mt];
      }
    }
    __syncthreads();
#pragma unroll
    for (int i = 0; i < NA; ++i) *(u32x4*)(sA + woff + 32 * i * 144) = ra[i];
    __syncthreads();
  }
  u16* ACT = P.R;
  const int j = ((n0 + w * 64) >> 1) + r;
#pragma unroll
  for (int mt = 0; mt < MT; ++mt)
#pragma unroll
    for (int i = 0; i < 16; ++i) {
      int row = m0 + mt * 32 + crow(i, h);
      float g = acc[mt][0][i], u = acc[mt][1][i];
      float a = g * frcp(1.f + __expf(-g)) * u;
      ACT[(size_t)row * DFF + j] = tobf(a);
    }
}

DI void gemm_phase_e1(const u16* A, const u16* Bt, int K, const Params& P, char* smem) {
  const int NT = 22, MT_ = NTOK / 128;
  const int tiles = MT_ * NT;
  for (int rd = 0; rd * (int)gridDim.x < tiles; ++rd) {
    const int t = xcd_tile(rd, tiles);
    if (t >= tiles) break;
    const int grp = t / (8 * NT), within = t % (8 * NT);
    const int tm = grp * 8 + (within & 7), tn = within >> 3;
    gemm_tile_e1(A, Bt, K, tm * 128, tn * 256, P, smem);
  }
}

DI void attn_prep_tile(const Params& P, int l, int t32) {
  const int lane = tidx() & 63, w = tidx() >> 6;
  const int hl = lane & 31, half = lane >> 5;
  const int d = 2 * hl;
  const u16* Z = P.R;
  const float QSCALE = 0.125f * 1.4426950408889634f;
  const float qn0 = P.qnorm[l * 64 + d], qn1 = P.qnorm[l * 64 + d + 1];
  const float kn0 = P.knorm[l * 64 + d], kn1 = P.knorm[l * 64 + d + 1];
  const int a = hl >> 4, second = (hl >> 3) & 1, f0 = 2 * (hl & 7);
  for (int tt = 0; tt < 8; ++tt) {
    const int token = t32 * 32 + w * 8 + tt;
    unsigned x[5];
#pragma unroll
    for (int i = 0; i < 5; ++i) x[i] = *(const unsigned*)(Z + (size_t)token * NZ + 2048 + (i * 2 + half) * 64 + d);
    const bool ctx = token < NCTX;
    const int p = (token - NCTX) & 2047, b = ctx ? (token >> 8) : ((token - NCTX) >> 11);
    const int pos = a ? (p & 63) : (p >> 6);
    f32x4 cs4 = {1.f, 0.f, 1.f, 0.f};
    if (!ctx) cs4 = *(const f32x4*)(P.rope + (pos * 16 + f0) * 2);
#pragma unroll
    for (int i = 0; i < 5; ++i) {
      const int hh = i * 2 + half;
      const float x0 = bflo(x[i]), x1 = bfhi(x[i]);
      float ss = x0 * x0 + x1 * x1;
#pragma unroll
      for (int o = 16; o >= 1; o >>= 1) ss += __shfl_xor(ss, o);
      const float rstd = rsqrtf(ss * (1.f / 64.f) + EPSF);
      float y0 = x0 * rstd * (hh < 8 ? qn0 : kn0), y1 = x1 * rstd * (hh < 8 ? qn1 : kn1);
      const float p0 = __shfl_xor(y0, 8), p1 = __shfl_xor(y1, 8);
      if (ctx) {
        if (hh < 8) {
          *(unsigned*)(P.Qb + (size_t)token * 512 + hh * 64 + d) = pk2(y0 * QSCALE, y1 * QSCALE);
        } else {
          const int kv = hh - 8, t = token & 255;
          f32x2 o = {y0, y1};
          *(f32x2*)(P.out + OUT_K + ((size_t)((b * 2 + l) * 256 + t) * 2 + kv) * 64 + d) = o;
          *(unsigned*)(P.Kc + ((size_t)(b * 2 + kv) * 256 + t) * 64 + d) = pk2(y0, y1);
        }
      } else {
        const float r0 = second ? (y0 * cs4.x + p0 * cs4.y) : (y0 * cs4.x - p0 * cs4.y);
        const float r1 = second ? (y1 * cs4.z + p1 * cs4.w) : (y1 * cs4.z - p1 * cs4.w);
        if (hh < 8) {
          *(unsigned*)(P.Qb + (size_t)token * 512 + hh * 64 + d) = pk2(r0 * QSCALE, r1 * QSCALE);
        } else {
          const int kv = hh - 8;
          *(unsigned*)(P.Kl + ((size_t)(b * 2 + kv) * 2560 + 512 + p) * 64 + d) = pk2(r0, r1);
        }
      }
    }
  }
}

DI void cache_item(const Params& P, int l, int idx, float* tile) {
  const int tid = tidx();
  const int b = idx >> 4, kv = (idx >> 3) & 1, pos0 = (idx & 7) * 64;
  for (int e = tid; e < 4096; e += 256) {
    int pos = e >> 6, d = e & 63;
    size_t src = ((size_t)((b * 2 + l) * 512 + pos0 + pos) * 2 + kv) * 64 + d;
    P.Kl[((size_t)(b * 2 + kv) * 2560 + pos0 + pos) * 64 + d] = tobf(P.cache_k[src]);
    tile[pos * 65 + d] = P.cache_v[src];
  }
  __syncthreads();
  const int pp = tid & 31;
#pragma unroll
  for (int i = 0; i < 8; ++i) {
    int d = (tid >> 5) + 8 * i;
    unsigned v = pk2(tile[(2 * pp) * 65 + d], tile[(2 * pp + 1) * 65 + d]);
    *(unsigned*)(P.Vl + ((size_t)(b * 2 + kv) * 64 + d) * 2560 + pos0 + 2 * pp) = v;
  }
  __syncthreads();
}

DI void dprep_item(const Params& P, int l, int item, char* smem) {
  const int tid = tidx(), lane = tid & 63, w = tid >> 6, r = lane & 31, h = lane >> 5;
  const int gc = item >> 2, hh = item & 3, r0 = gc * 64;
  int s0, slen;
  if (r0 < NCTX) { s0 = r0 & ~255; slen = 256; } else { s0 = NCTX + ((r0 - NCTX) & ~2047); slen = 2048; }
  u16* sq = (u16*)smem;
  u16* sk = sq + 64 * 72;
  u16* sv = sk + 64 * 72;
  float* Ls = (float*)(smem + 27648);
  float* gcs = (float*)(smem + 27648 + 32768);
  float* bts = gcs + 128;
  float* egs = gcs + 256;
  const u16* Z = P.R;
  const int grp = tid >> 5, cp = tid & 31;
  if (grp < 6) {
    const int which = grp % 3, seg = grp / 3;
    const int chn = which * 256 + hh * 64 + 2 * cp;
    const int zc = 1024 + chn;
    float cw0[5], cw1[5];
#pragma unroll
    for (int wi = 0; wi < 5; ++wi) {
      cw0[wi] = P.dconv[(size_t)(l * 5 + wi) * 768 + chn];
      cw1[wi] = P.dconv[(size_t)(l * 5 + wi) * 768 + chn + 1];
    }
    const int rbase = r0 + seg * 32;
    const int send = s0 + slen;
    unsigned uu[36];
#pragma unroll
    for (int i = 0; i < 36; ++i) {
      const int rr = rbase - 2 + i;
      uu[i] = (rr >= s0 && rr < send) ? *(const unsigned*)(Z + (size_t)rr * NZ + zc) : 0u;
    }
    u16* dst = which == 0 ? sq : (which == 1 ? sk : sv);
#pragma unroll
    for (int t = 0; t < 32; ++t) {
      float y0 = bflo(uu[t]) * cw0[0] + bflo(uu[t + 1]) * cw0[1] + bflo(uu[t + 2]) * cw0[2] + bflo(uu[t + 3]) * cw0[3] + bflo(uu[t + 4]) * cw0[4];
      float y1 = bfhi(uu[t]) * cw1[0] + bfhi(uu[t + 1]) * cw1[1] + bfhi(uu[t + 2]) * cw1[2] + bfhi(uu[t + 3]) * cw1[3] + bfhi(uu[t + 4]) * cw1[4];
      y0 = y0 * frcp(1.f + __expf(-y0));
      y1 = y1 * frcp(1.f + __expf(-y1));
      float ss = y0 * y0 + y1 * y1;
#pragma unroll
      for (int o = 16; o >= 1; o >>= 1) ss += __shfl_xor(ss, o);
      if (which < 2) {
        float rn = rsqrtf(ss + EPSF);
        if (which == 0) rn *= 0.125f;
        y0 *= rn;
        y1 *= rn;
      }
      *(unsigned*)(dst + (seg * 32 + t) * 72 + 2 * cp) = pk2(y0, y1);
    }
  } else {
#pragma unroll
    for (int dir = 0; dir < 2; ++dir) {
      const float graw = P.Zg[(size_t)(r0 + lane) * 32 + 16 + dir * 4 + hh];
      const float braw = P.Zg[(size_t)(r0 + lane) * 32 + 24 + dir * 4 + hh];
      const float Aa = -expf(P.alog[(l * 2 + dir) * 4 + hh]);
      const float x = graw + P.dtb[(l * 2 + dir) * 4 + hh];
      const float sp = x > 20.f ? x : log1pf(expf(x));
      float v = Aa * sp;
      if (dir == 0) {
#pragma unroll
        for (int o = 1; o < 64; o <<= 1) { float t = __shfl_up(v, o); if (lane >= o) v += t; }
      } else {
#pragma unroll
        for (int o = 1; o < 64; o <<= 1) { float t = __shfl_down(v, o); if (lane + o < 64) v += t; }
      }
      const int li = dir ? 63 - lane : lane;
      const float bt = sigmoidf_(braw);
      gcs[dir * 64 + li] = v;
      bts[dir * 64 + li] = bt;
      egs[dir * 64 + li] = bt * __expf(v);
    }
  }
  __syncthreads();
  {
    const int dir = w >> 1, it = w & 1;
    const float* gcd = gcs + dir * 64;
    const float* btd = bts + dir * 64;
    u16* base = P.dprep + (size_t)(item * 2 + dir) * 20480;
    const int ti_a = 32 * it + r;
    const int tr_a = dir ? 63 - ti_a : ti_a;
    s16x8 qa[4], ka[4];
#pragma unroll
    for (int ks = 0; ks < 4; ++ks) {
      qa[ks] = *(const s16x8*)(sq + tr_a * 72 + ks * 16 + h * 8);
      ka[ks] = *(const s16x8*)(sk + tr_a * 72 + ks * 16 + h * 8);
    }
#pragma unroll
    for (int jt = 0; jt < 2; ++jt) {
      const int tj = 32 * jt + r;
      const int tr_b = dir ? 63 - tj : tj;
      f32x16 G = zero16(), QK = zero16();
      if (jt <= it) {
#pragma unroll
        for (int ks = 0; ks < 4; ++ks) {
          s16x8 kb = *(const s16x8*)(sk + tr_b * 72 + ks * 16 + h * 8);
          G = mfma(ka[ks], kb, G);
          QK = mfma(qa[ks], kb, QK);
        }
      }
      const float gj = gcd[tj];
#pragma unroll
      for (int reg = 0; reg < 16; ++reg) {
        const int i = 32 * it + crow(reg, h);
        const float gi = gcd[i], bi = btd[i];
        const float dec = __expf(fminf(gi - gj, 0.f));
        if (jt <= it) Ls[(dir * 64 + i) * 64 + tj] = bi * G[reg] * dec;
        const float qkv = (tj <= i && jt <= it) ? QK[reg] * dec : 0.f;
        base[16384 + apos(i, tj)] = tobf(qkv);
      }
    }
  }
  __syncthreads();
  {
    const int dir = w >> 1, which = w & 1, c = lane;
    const float* Ld = Ls + dir * 4096;
    u16* base = P.dprep + (size_t)(item * 2 + dir) * 20480;
    float x[64];
    const int step = dir ? -72 : 72;
    const u16* pr = (which == 0 ? sv : sk) + (dir ? 63 * 72 : 0) + c;
    const float* scl = (which == 0 ? bts : egs) + dir * 64;
#pragma unroll
    for (int t = 0; t < 64; ++t) {
      float a = bf1(*pr) * scl[t];
      pr += step;
      asm volatile("" : "+v"(pr));
      float a1 = 0.f, a2 = 0.f, a3 = 0.f;
#pragma unroll
      for (int j = 0; j < t; ++j) {
        const float pv = Ld[t * 64 + j] * x[j];
        if ((j & 3) == 0) a -= pv;
        else if ((j & 3) == 1) a1 -= pv;
        else if ((j & 3) == 2) a2 -= pv;
        else a3 -= pv;
      }
      a = (a + a1) + (a2 + a3);
      x[t] = a;
      asm volatile("" ::: "memory");
    }
    if (which == 0) {
      u16* ub = base + ((c >> 5) * 8 * 64 + (c & 31)) * 4;
#pragma unroll
      for (int tt = 0; tt < 2; ++tt)
#pragma unroll
        for (int g = 0; g < 4; ++g)
#pragma unroll
          for (int hp = 0; hp < 2; ++hp) {
            const int t0 = 32 * tt + 8 * g + 4 * hp;
            u32x2 o = {pk2(x[t0], x[t0 + 1]), pk2(x[t0 + 2], x[t0 + 3])};
            *(u32x2*)(ub + ((tt * 4 + g) * 64 + hp * 32) * 4) = o;
          }
    } else {
      u16* wb = base + 4096 + apos(0, c);
#pragma unroll
      for (int t = 0; t < 64; ++t) wb[(t >> 5) * 2048 + (t & 31) * 8] = tobf(x[t]);
    }
  }
#pragma unroll
  for (int dir = 0; dir < 2; ++dir) {
    u16* base = P.dprep + (size_t)(item * 2 + dir) * 20480;
    const float glast = gcs[dir * 64 + 63];
    for (int e = tid; e < 4096; e += 256) {
      const int t = e >> 6, d = e & 63;
      const int tr = dir ? 63 - t : t;
      base[8192 + apos(t, d)] = tobf(bf1(sq[tr * 72 + d]) * __expf(gcs[dir * 64 + t]));
    }
    for (int e = tid; e < 4096; e += 256) {
      const int d = e >> 6, t = e & 63;
      const int tr = dir ? 63 - t : t;
      base[12288 + apos(d, t)] = tobf(bf1(sk[tr * 72 + d]) * __expf(glast - gcs[dir * 64 + t]));
    }
    if (tid == 0) P.dgl[item * 2 + dir] = __expf(glast);
  }
  __syncthreads();
}

DI void mprep_item(const Params& P, int l, int item, float* wsm_all);
DI void prep_phase(const Params& P, int l, char* smem) {
  if (gridDim.x == 512) {
    const int b = blockIdx.x;
    if (b < 256) {
      dprep_item(P, l, b, smem);
      dprep_item(P, l, 512 + b, smem);
      mprep_item(P, l, b, (float*)smem);
      __syncthreads();
    } else {
      const int k = b - 256;
      dprep_item(P, l, 256 + k, smem);
      mprep_item(P, l, 256 + k, (float*)smem);
      __syncthreads();
      mprep_item(P, l, 512 + k, (float*)smem);
      __syncthreads();
      attn_prep_tile(P, l, k);
      if (k < 128) attn_prep_tile(P, l, 256 + k);
      else if (k < 192) cache_item(P, l, k - 128, (float*)smem);
    }
    return;
  }
  const int total = 768 + 768 + 384 + 64;
  for (int item = blockIdx.x; item < total; item += gridDim.x) {
    if (item < 768) dprep_item(P, l, item, smem);
    else if (item < 1536) { mprep_item(P, l, item - 768, (float*)smem); __syncthreads(); }
    else if (item < 1920) attn_prep_tile(P, l, item - 1536);
    else cache_item(P, l, item - 1920, (float*)smem);
  }
}

DI void mprep_item(const Params& P, int l, int item, float* wsm_all) {
  const int lane = tidx() & 63, w = tidx() >> 6, r = lane & 31, h = lane >> 5;
  const int dir = w >> 1, et = w & 1;
  const int gc = item >> 2, hh = item & 3, r0 = gc * 64;
  const int cidx = (gc * 4 + hh) * 2 + dir;
  float* wL = wsm_all + w * 64;
  const float fb = P.fbias[(l * 2 + dir) * 4 + hh];
  const int ll = dir ? 0 : 63;
  const float ig = P.Zg[(size_t)(r0 + lane) * 32 + dir * 4 + hh];
  const float fp = P.Zg[(size_t)(r0 + lane) * 32 + 8 + dir * 4 + hh] + fb;
  const float lf = fminf(fp, 0.f) - log1pf(__expf(-fabsf(fp)));
  float bs = lf;
  if (dir == 0) {
#pragma unroll
    for (int o = 1; o < 64; o <<= 1) { float t = __shfl_up(bs, o); if (lane >= o) bs += t; }
  } else {
#pragma unroll
    for (int o = 1; o < 64; o <<= 1) { float t = __shfl_down(bs, o); if (lane + o < 64) bs += t; }
  }
  const float a = ig - bs;
  float cm = a;
  if (dir == 0) {
#pragma unroll
    for (int o = 1; o < 64; o <<= 1) { float t = __shfl_up(cm, o); if (lane >= o) cm = fmaxf(cm, t); }
  } else {
#pragma unroll
    for (int o = 1; o < 64; o <<= 1) { float t = __shfl_down(cm, o); if (lane + o < 64) cm = fmaxf(cm, t); }
  }
  const float bl = __shfl(bs, ll);
  const float cml = __shfl(cm, ll);
  wL[lane] = __expf(a - cml) * 0.125f;
  if (et == 0) {
    const size_t gi = ((size_t)dir * NTOK + r0 + lane) * 4 + hh;
    P.mg_a[gi] = a;
    P.mg_b[gi] = bs;
    P.mg_cm[gi] = cm;
    if (lane == 0) { P.mchunk[cidx * 2] = bl; P.mchunk[cidx * 2 + 1] = cml; }
  }
  __builtin_amdgcn_fence(__ATOMIC_RELEASE, "wavefront");
  __builtin_amdgcn_wave_barrier();
  __builtin_amdgcn_fence(__ATOMIC_ACQUIRE, "wavefront");
  s16x8 Vf[2][2];
  const u16* vt = P.VTm + ((size_t)(gc * 4 + hh) * 64 + 32 * et + r) * 64;
#pragma unroll
  for (int jt = 0; jt < 2; ++jt)
#pragma unroll
    for (int s = 0; s < 2; ++s) Vf[jt][s] = ldperm(vt + 32 * jt + 16 * s, h);
  const u16* kt = P.KTm + ((size_t)(gc * 4 + hh) * 64 + r) * 64;
  u16* dstU = P.Ubuf + (size_t)(cidx * 2 + et) * 2048;
#pragma unroll
  for (int dt = 0; dt < 2; ++dt) {
    f32x16 U = zero16();
    float rs = 0.f;
#pragma unroll
    for (int jt = 0; jt < 2; ++jt)
#pragma unroll
      for (int s = 0; s < 2; ++s) {
        const u16* pk = kt + (32 * dt) * 64 + 32 * jt + 16 * s;
        const u32x2 lo = *(const u32x2*)(pk + 4 * h);
        const u32x2 hi = *(const u32x2*)(pk + 8 + 4 * h);
        const f32x4 w0 = *(const f32x4*)(wL + 32 * jt + 16 * s + 4 * h);
        const f32x4 w1 = *(const f32x4*)(wL + 32 * jt + 16 * s + 8 + 4 * h);
        const float v0 = bflo(lo.x) * w0.x, v1 = bfhi(lo.x) * w0.y, v2 = bflo(lo.y) * w0.z, v3 = bfhi(lo.y) * w0.w;
        const float v4 = bflo(hi.x) * w1.x, v5 = bfhi(hi.x) * w1.y, v6 = bflo(hi.y) * w1.z, v7 = bfhi(hi.y) * w1.w;
        rs += ((v0 + v1) + (v2 + v3)) + ((v4 + v5) + (v6 + v7));
        u32x4 fr = {pk2(v0, v1), pk2(v2, v3), pk2(v4, v5), pk2(v6, v7)};
        U = mfma(__builtin_bit_cast(s16x8, fr), Vf[jt][s], U);
      }
    rs += __shfl_xor(rs, 32);
#pragma unroll
    for (int g = 0; g < 4; ++g) {
      u32x2 o = {pk2(U[4 * g], U[4 * g + 1]), pk2(U[4 * g + 2], U[4 * g + 3])};
      *(u32x2*)(dstU + ((dt * 4 + g) * 64 + lane) * 4) = o;
    }
    if (et == 0 && h == 0) P.nUbuf[cidx * 64 + 32 * dt + r] = rs;
  }
  __builtin_amdgcn_fence(__ATOMIC_RELEASE, "wavefront");
  __builtin_amdgcn_wave_barrier();
}

DI void mstate_item(const Params& P, int l, int seq, int hh) {
  const int lane = tidx() & 63, w = tidx() >> 6, r = lane & 31, h = lane >> 5;
  const int dir = w >> 1, et = w & 1;
  const bool latent = seq >= 16;
  const int nc = latent ? 32 : 4;
  const int gc0 = latent ? 64 + (seq - 16) * 32 : seq * 4;
  const int b = latent ? seq - 16 : seq;
  const int sidx = ((b * 2 + l) * 2 + dir) * 4 + hh;
  f32x16 C[2];
  float nreg = 0.f, m = 0.f;
  C[0] = zero16();
  C[1] = zero16();
  if (latent) {
    const float* sc = P.stC + (size_t)sidx * 4096 + 32 * et + r;
#pragma unroll
    for (int dt = 0; dt < 2; ++dt)
#pragma unroll
      for (int reg = 0; reg < 16; ++reg) C[dt][reg] = sc[(32 * dt + crow(reg, 0) + 4 * h) * 64];
    nreg = P.stn[(size_t)sidx * 64 + lane];
    m = P.stm[sidx];
  }
  u32x2 uA[8], uB[8];
  float nuA, blA, cmlA, nuB = 0.f, blB = 0.f, cmlB = 0.f;
#define MST_LOAD(UU, NU, BL, CML, cc)                                                        \
  {                                                                                          \
    const int gcl_ = gc0 + (dir ? nc - 1 - (cc) : (cc));                                     \
    const int cil_ = (gcl_ * 4 + hh) * 2 + dir;                                              \
    const u16* srcU_ = P.Ubuf + (size_t)(cil_ * 2 + et) * 2048;                              \
    _Pragma("unroll") for (int q = 0; q < 8; ++q) UU[q] = *(const u32x2*)(srcU_ + (q * 64 + lane) * 4); \
    NU = P.nUbuf[cil_ * 64 + lane];                                                          \
    BL = P.mchunk[cil_ * 2];                                                                 \
    CML = P.mchunk[cil_ * 2 + 1];                                                            \
  }
#define MST_STEP(UU, NU, BL, CML, cc)                                                        \
  {                                                                                          \
    const int gcc_ = gc0 + (dir ? nc - 1 - (cc) : (cc));                                     \
    const int cidx_ = (gcc_ * 4 + hh) * 2 + dir;                                             \
    u16* dstC_ = P.Cst + (size_t)(cidx_ * 2 + et) * 2048;                                    \
    _Pragma("unroll") for (int dt = 0; dt < 2; ++dt)                                         \
      _Pragma("unroll") for (int s2 = 0; s2 < 2; ++s2)                                       \
        *(s16x8*)(dstC_ + ((dt * 2 + s2) * 64 + lane) * 8) = pack8(C[dt], s2);               \
    if (et == 0) {                                                                           \
      P.nst[cidx_ * 64 + lane] = nreg;                                                       \
      if (lane == 0) P.mst[cidx_] = m;                                                       \
    }                                                                                        \
    const float Mlast_ = fmaxf(m, CML);                                                      \
    const float dec_ = __expf(m - Mlast_), f_ = __expf(CML - Mlast_);                        \
    _Pragma("unroll") for (int dt = 0; dt < 2; ++dt)                                         \
      _Pragma("unroll") for (int g = 0; g < 4; ++g) {                                        \
        const u32x2 u2 = UU[dt * 4 + g];                                                     \
        C[dt][4 * g + 0] = dec_ * C[dt][4 * g + 0] + f_ * bflo(u2.x);                        \
        C[dt][4 * g + 1] = dec_ * C[dt][4 * g + 1] + f_ * bfhi(u2.x);                        \
        C[dt][4 * g + 2] = dec_ * C[dt][4 * g + 2] + f_ * bflo(u2.y);                        \
        C[dt][4 * g + 3] = dec_ * C[dt][4 * g + 3] + f_ * bfhi(u2.y);                        \
      }                                                                                      \
    nreg = dec_ * nreg + f_ * NU;                                                            \
    m = BL + Mlast_;                                                                         \
  }
  MST_LOAD(uA, nuA, blA, cmlA, 0)
  for (int c = 0; c < nc; c += 2) {
    MST_LOAD(uB, nuB, blB, cmlB, c + 1)
    MST_STEP(uA, nuA, blA, cmlA, c)
    if (c + 2 < nc) MST_LOAD(uA, nuA, blA, cmlA, c + 2)
    MST_STEP(uB, nuB, blB, cmlB, c + 1)
  }
#undef MST_LOAD
#undef MST_STEP
  if (!latent) {
#pragma unroll
    for (int dt = 0; dt < 2; ++dt)
#pragma unroll
      for (int reg = 0; reg < 16; ++reg) {
        const int d = 32 * dt + crow(reg, h), e = 32 * et + r;
        P.out[OUT_C + ((size_t)sidx * 64 + d) * 64 + e] = C[dt][reg];
      }
    if (et == 0) {
      P.out[OUT_N + (size_t)sidx * 64 + lane] = nreg;
      if (lane == 0) P.out[OUT_M + sidx] = m;
    }
  }
}

DI void combine_dirs(const Params& P, int l, int r0, int hh, const float* hbuf, bool is_m) {
  const int tid = tidx();
  const int i = tid >> 2, part = tid & 3, e0 = part * 16;
  const int tok = r0 + i;
  float sv[16];
  float ss = 0.f;
#pragma unroll
  for (int q = 0; q < 4; ++q) {
    const f32x4 x0 = *(const f32x4*)(hbuf + (size_t)(i)*68 + e0 + 4 * q);
    const f32x4 x1 = *(const f32x4*)(hbuf + (size_t)(64 + i) * 68 + e0 + 4 * q);
    sv[4 * q + 0] = x0.x + x1.x; sv[4 * q + 1] = x0.y + x1.y; sv[4 * q + 2] = x0.z + x1.z; sv[4 * q + 3] = x0.w + x1.w;
    ss += sv[4 * q] * sv[4 * q] + sv[4 * q + 1] * sv[4 * q + 1] + sv[4 * q + 2] * sv[4 * q + 2] + sv[4 * q + 3] * sv[4 * q + 3];
  }
  ss += __shfl_xor(ss, 1);
  ss += __shfl_xor(ss, 2);
  const float rstd = rsqrtf(ss * (1.f / 64.f) + EPSF);
  const float* wv = is_m ? P.mnorm + l * 256 + hh * 64 + e0 : P.dnorm + l * 64 + e0;
  const u16* gz = P.R + (size_t)tok * NZ + (is_m ? 768 : 1792) + hh * 64 + e0;
  const u32x4 g0 = *(const u32x4*)(gz), g1 = *(const u32x4*)(gz + 8);
  unsigned gw[8] = {g0.x, g0.y, g0.z, g0.w, g1.x, g1.y, g1.z, g1.w};
  unsigned ow[8];
#pragma unroll
  for (int q = 0; q < 8; ++q) {
    const float ga = bflo(gw[q]), gb = bfhi(gw[q]);
    const float ma = is_m ? sigmoidf_(ga) : ga * sigmoidf_(ga);
    const float mb = is_m ? sigmoidf_(gb) : gb * sigmoidf_(gb);
    ow[q] = pk2(sv[2 * q] * rstd * wv[2 * q] * ma, sv[2 * q + 1] * rstd * wv[2 * q + 1] * mb);
  }
  u16* dst = P.H + (size_t)tok * 1024 + (is_m ? 0 : 256) + hh * 64 + e0;
  u32x4 o0 = {ow[0], ow[1], ow[2], ow[3]}, o1 = {ow[4], ow[5], ow[6], ow[7]};
  *(u32x4*)(dst) = o0;
  *(u32x4*)(dst + 8) = o1;
}

DI void mout_item(const Params& P, int l, int item, char* smem) {
  const int lane = tidx() & 63, w = tidx() >> 6, r = lane & 31, h = lane >> 5;
  const int dir = w >> 1, et = w & 1;
  const int gc = item >> 2, hh = item & 3, r0 = gc * 64;
  const int cidx = (gc * 4 + hh) * 2 + dir;
  float* hbuf = (float*)smem;
  float* aL = (float*)(smem + 34816) + w * 128;
  float* nL = aL + 64;
  const u16* Z = P.R;
  aL[lane] = P.mg_a[((size_t)dir * NTOK + r0 + lane) * 4 + hh];
  nL[lane] = P.nst[cidx * 64 + lane];
  const float m = P.mst[cidx];
  __builtin_amdgcn_fence(__ATOMIC_RELEASE, "wavefront");
  __builtin_amdgcn_wave_barrier();
  __builtin_amdgcn_fence(__ATOMIC_ACQUIRE, "wavefront");
  s16x8 Vf[2][2], Cb[2][2];
  const u16* vt = P.VTm + ((size_t)(gc * 4 + hh) * 64 + 32 * et + r) * 64;
#pragma unroll
  for (int jt = 0; jt < 2; ++jt)
#pragma unroll
    for (int s = 0; s < 2; ++s) Vf[jt][s] = ldperm(vt + 32 * jt + 16 * s, h);
  const u16* srcC = P.Cst + (size_t)(cidx * 2 + et) * 2048;
#pragma unroll
  for (int dt = 0; dt < 2; ++dt)
#pragma unroll
    for (int s = 0; s < 2; ++s) Cb[dt][s] = *(const s16x8*)(srcC + ((dt * 2 + s) * 64 + lane) * 8);
#pragma unroll
  for (int it = 0; it < 2; ++it) {
    const int i = 32 * it + r;
    const size_t gi = ((size_t)dir * NTOK + r0 + i) * 4 + hh;
    const float Mi = fmaxf(m, P.mg_cm[gi]), bi = P.mg_b[gi];
    s16x8 Qf[4];
#pragma unroll
    for (int ks = 0; ks < 4; ++ks) Qf[ks] = ldperm(Z + (size_t)(r0 + i) * NZ + hh * 64 + 16 * ks, h);
    f32x16 NUM = zero16();
    float den = 0.f;
#pragma unroll
    for (int jt = 0; jt < 2; ++jt) {
      f32x16 ST = zero16();
#pragma unroll
      for (int ks = 0; ks < 4; ++ks)
        ST = mfma(ldperm(Z + (size_t)(r0 + 32 * jt + r) * NZ + 256 + hh * 64 + 16 * ks, h), Qf[ks], ST);
#pragma unroll
      for (int reg = 0; reg < 16; ++reg) {
        const int j = 32 * jt + crow(reg, h);
        const bool ok = dir ? (j >= i) : (j <= i);
        const float p = ok ? ST[reg] * 0.125f * __expf(aL[j] - Mi) : 0.f;
        ST[reg] = p;
        den += p;
      }
#pragma unroll
      for (int s = 0; s < 2; ++s) NUM = mfma(Vf[jt][s], pack8(ST, s), NUM);
    }
    f32x16 INT = zero16();
    float qn = 0.f;
#pragma unroll
    for (int dt = 0; dt < 2; ++dt)
#pragma unroll
      for (int s = 0; s < 2; ++s) {
        INT = mfma(Cb[dt][s], Qf[dt * 2 + s], INT);
        const f32x4 n0 = *(const f32x4*)(nL + 32 * dt + 16 * s + 4 * h);
        const f32x4 n1 = *(const f32x4*)(nL + 32 * dt + 16 * s + 8 + 4 * h);
        const u32x4 qq = __builtin_bit_cast(u32x4, Qf[dt * 2 + s]);
        qn += bflo(qq[0]) * n0.x + bfhi(qq[0]) * n0.y + bflo(qq[1]) * n0.z + bfhi(qq[1]) * n0.w;
        qn += bflo(qq[2]) * n1.x + bfhi(qq[2]) * n1.y + bflo(qq[3]) * n1.z + bfhi(qq[3]) * n1.w;
      }
    den += __shfl_xor(den, 32);
    qn += __shfl_xor(qn, 32);
    const float aint = __expf(m - Mi);
    const float dn = den + aint * qn;
    const float mt = bi + Mi;
    const float inv = 1.f / fmaxf(fabsf(dn), __expf(-mt));
    float* hb = hbuf + (size_t)(dir * 64 + i) * 68 + 32 * et + 4 * h;
#pragma unroll
    for (int g = 0; g < 4; ++g) {
      f32x4 o = {(NUM[4 * g + 0] + aint * INT[4 * g + 0]) * inv, (NUM[4 * g + 1] + aint * INT[4 * g + 1]) * inv,
                 (NUM[4 * g + 2] + aint * INT[4 * g + 2]) * inv, (NUM[4 * g + 3] + aint * INT[4 * g + 3]) * inv};
      *(f32x4*)(hb + 8 * g) = o;
    }
  }
  __syncthreads();
  combine_dirs(P, l, r0, hh, hbuf, true);
  __syncthreads();
}

DI void dstate_item(const Params& P, int l, int seq, int hh) {
  const int lane = tidx() & 63, w = tidx() >> 6, r = lane & 31, h = lane >> 5;
  const int dir = w >> 1, et = w & 1;
  const bool latent = seq >= 16;
  const int nc = latent ? 32 : 4;
  const int gc0 = latent ? 64 + (seq - 16) * 32 : seq * 4;
  const int b = latent ? seq - 16 : seq;
  f32x16 S[2];
  S[0] = zero16();
  S[1] = zero16();
  if (latent) {
    const float* sc = P.stS + (size_t)(((b * 2 + l) * 2 + dir) * 4 + hh) * 4096 + 32 * et + r;
#pragma unroll
    for (int dt = 0; dt < 2; ++dt)
#pragma unroll
      for (int reg = 0; reg < 16; ++reg) S[dt][reg] = sc[(32 * dt + crow(reg, 0) + 4 * h) * 64];
  }
  s16x8 WA[2][4], WB[2][4];
  unsigned wmA = 0, wmB = 0, wmC = 0;
#define DST_LOAD(WW, cc)                                                                     \
  {                                                                                          \
    const int gcl_ = gc0 + (dir ? nc - 1 - (cc) : (cc));                                     \
    const int cil_ = (gcl_ * 4 + hh) * 2 + dir;                                              \
    const u16* bl_ = P.dprep + (size_t)cil_ * 20480;                                         \
    _Pragma("unroll") for (int tt = 0; tt < 2; ++tt)                                         \
      _Pragma("unroll") for (int ks = 0; ks < 4; ++ks)                                       \
        WW[tt][ks] = *(const s16x8*)(bl_ + 4096 + ((tt * 4 + ks) * 64 + lane) * 8);         \
      \
    asm volatile("s_waitcnt vmcnt(0)" ::: "memory");                                         \
    warm_use(wmA); warm_use(wmB);                                                            \
    wmA = warm_issue((const char*)bl_ + (size_t)(et * 32 + (lane & 31)) * 128);              \
    wmB = warm_issue((const char*)bl_ + 24576 + (size_t)lane * 128);                         \
  }
#define DST_STEP(WW, cc)                                                                     \
  {                                                                                          \
    const int gcc_ = gc0 + (dir ? nc - 1 - (cc) : (cc));                                     \
    const int cidx_ = (gcc_ * 4 + hh) * 2 + dir;                                             \
    const u16* base_ = P.dprep + (size_t)cidx_ * 20480;                                      \
    const float GL = P.dgl[cidx_];                                                           \
    u32x2 UU[2][4];                                                                          \
    _Pragma("unroll") for (int tt = 0; tt < 2; ++tt)                                         \
      _Pragma("unroll") for (int g = 0; g < 4; ++g)                                          \
        UU[tt][g] = *(const u32x2*)(base_ + (((et * 2 + tt) * 4 + g) * 64 + lane) * 4);      \
    s16x8 Kd[2][4];                                                                          \
    _Pragma("unroll") for (int dt = 0; dt < 2; ++dt)                                         \
      _Pragma("unroll") for (int ks = 0; ks < 4; ++ks)                                       \
        Kd[dt][ks] = *(const s16x8*)(base_ + 12288 + ((dt * 4 + ks) * 64 + lane) * 8);       \
    s16x8 Sb[2][2];                                                                          \
    _Pragma("unroll") for (int dt = 0; dt < 2; ++dt)                                         \
      _Pragma("unroll") for (int s2 = 0; s2 < 2; ++s2) Sb[dt][s2] = pack8(S[dt], s2);        \
    u16* dstS_ = P.Sst + (size_t)(cidx_ * 2 + et) * 2048;                                    \
    _Pragma("unroll") for (int dt = 0; dt < 2; ++dt)                                         \
      _Pragma("unroll") for (int s2 = 0; s2 < 2; ++s2)                                       \
        *(s16x8*)(dstS_ + ((dt * 2 + s2) * 64 + lane) * 8) = Sb[dt][s2];                     \
    s16x8 Vb[2][2];                                                                          \
    _Pragma("unroll") for (int tt = 0; tt < 2; ++tt) {                                       \
      f32x16 WS = zero16();                                                                  \
      _Pragma("unroll") for (int dt = 0; dt < 2; ++dt)                                       \
        _Pragma("unroll") for (int s2 = 0; s2 < 2; ++s2) WS = mfma(WW[tt][dt * 2 + s2], Sb[dt][s2], WS); \
      _Pragma("unroll") for (int g = 0; g < 4; ++g) {                                        \
        const u32x2 u2 = UU[tt][g];                                                          \
        WS[4 * g + 0] = bflo(u2.x) - WS[4 * g + 0];                                          \
        WS[4 * g + 1] = bfhi(u2.x) - WS[4 * g + 1];                                          \
        WS[4 * g + 2] = bflo(u2.y) - WS[4 * g + 2];                                          \
        WS[4 * g + 3] = bfhi(u2.y) - WS[4 * g + 3];                                          \
      }                                                                                      \
      _Pragma("unroll") for (int s2 = 0; s2 < 2; ++s2) Vb[tt][s2] = pack8(WS, s2);           \
    }                                                                                        \
    _Pragma("unroll") for (int dt = 0; dt < 2; ++dt) {                                       \
      _Pragma("unroll") for (int reg = 0; reg < 16; ++reg) S[dt][reg] *= GL;                 \
      _Pragma("unroll") for (int tt = 0; tt < 2; ++tt)                                       \
        _Pragma("unroll") for (int s2 = 0; s2 < 2; ++s2) S[dt] = mfma(Kd[dt][tt * 2 + s2], Vb[tt][s2], S[dt]); \
    }                                                                                        \
  }
  DST_LOAD(WA, 0)
  for (int c = 0; c < nc; c += 2) {
    DST_LOAD(WB, c + 1)
    DST_STEP(WA, c)
    if (c + 2 < nc) DST_LOAD(WA, c + 2)
    DST_STEP(WB, c + 1)
  }
  asm volatile("s_waitcnt vmcnt(0)" ::: "memory");
  warm_use(wmA); warm_use(wmB); warm_use(wmC);
#undef DST_LOAD
#undef DST_STEP
  if (!latent) {
#pragma unroll
    for (int dt = 0; dt < 2; ++dt)
#pragma unroll
      for (int reg = 0; reg < 16; ++reg) {
        const int d = 32 * dt + crow(reg, h), e = 32 * et + r;
        P.out[OUT_S + ((size_t)(((b * 2 + l) * 2 + dir) * 4 + hh) * 64 + d) * 64 + e] = S[dt][reg];
      }
  }
}

DI void dout_item(const Params& P, int l, int item, char* smem) {
  const int lane = tidx() & 63, w = tidx() >> 6, r = lane & 31, h = lane >> 5;
  const int dir = w >> 1, et = w & 1;
  const int gc = item >> 2, hh = item & 3, r0 = gc * 64;
  const int cidx = (gc * 4 + hh) * 2 + dir;
  float* hbuf = (float*)smem;
  const u16* base = P.dprep + (size_t)cidx * 20480;
  s16x8 Sb[2][2];
  const u16* srcS = P.Sst + (size_t)(cidx * 2 + et) * 2048;
#pragma unroll
  for (int dt = 0; dt < 2; ++dt)
#pragma unroll
    for (int s = 0; s < 2; ++s) Sb[dt][s] = *(const s16x8*)(srcS + ((dt * 2 + s) * 64 + lane) * 8);
  s16x8 Vb[2][2];
#pragma unroll
  for (int tt = 0; tt < 2; ++tt) {
    f32x16 WS = zero16();
#pragma unroll
    for (int dt = 0; dt < 2; ++dt)
#pragma unroll
      for (int s = 0; s < 2; ++s)
        WS = mfma(*(const s16x8*)(base + 4096 + ((tt * 4 + dt * 2 + s) * 64 + lane) * 8), Sb[dt][s], WS);
#pragma unroll
    for (int g = 0; g < 4; ++g) {
      u32x2 uu = *(const u32x2*)(base + (((et * 2 + tt) * 4 + g) * 64 + lane) * 4);
      WS[4 * g + 0] = bflo(uu.x) - WS[4 * g + 0];
      WS[4 * g + 1] = bfhi(uu.x) - WS[4 * g + 1];
      WS[4 * g + 2] = bflo(uu.y) - WS[4 * g + 2];
      WS[4 * g + 3] = bfhi(uu.y) - WS[4 * g + 3];
    }
#pragma unroll
    for (int s = 0; s < 2; ++s) Vb[tt][s] = pack8(WS, s);
  }
#pragma unroll
  for (int t2 = 0; t2 < 2; ++t2) {
    f32x16 QS = zero16();
#pragma unroll
    for (int dt = 0; dt < 2; ++dt)
#pragma unroll
      for (int s = 0; s < 2; ++s)
        QS = mfma(*(const s16x8*)(base + 8192 + ((t2 * 4 + dt * 2 + s) * 64 + lane) * 8), Sb[dt][s], QS);
#pragma unroll
    for (int tt = 0; tt <= t2; ++tt)
#pragma unroll
      for (int s = 0; s < 2; ++s)
        QS = mfma(*(const s16x8*)(base + 16384 + ((t2 * 4 + tt * 2 + s) * 64 + lane) * 8), Vb[tt][s], QS);
#pragma unroll
    for (int reg = 0; reg < 16; ++reg) {
      const int t = 32 * t2 + crow(reg, h);
      const int ti = dir ? 63 - t : t;
      hbuf[(size_t)(dir * 64 + ti) * 68 + 32 * et + r] = QS[reg];
    }
  }
  __syncthreads();
  combine_dirs(P, l, r0, hh, hbuf, false);
  __syncthreads();
}

DI void output_phase(const Params& P, int l, char* smem) {
  for (int item = blockIdx.x; item < 1536; item += gridDim.x) {
    if (item < 768) mout_item(P, l, item, smem);
    else dout_item(P, l, item - 768, smem);
  }
}

DI void attn_item(const Params& P, bool latent, int idx, char* smem) {
  const int tid = tidx(), lane = tid & 63, w = tid >> 6, r = lane & 31, h = lane >> 5;
  int b, hq, qt, qrow0, nk, vstride;
  const u16 *Kp, *Vp;
  if (latent) {
    b = idx >> 7; hq = (idx >> 4) & 7; qt = idx & 15;
    qrow0 = NCTX + b * 2048 + qt * 128;
    Kp = P.Kl + (size_t)(b * 2 + (hq >> 2)) * 2560 * 64;
    Vp = P.Vl + (size_t)(b * 2 + (hq >> 2)) * 64 * 2560;
    nk = 2560; vstride = 2560;
  } else {
    b = idx >> 4; hq = (idx >> 1) & 7; qt = idx & 1;
    qrow0 = b * 256 + qt * 128;
    Kp = P.Kc + (size_t)(b * 2 + (hq >> 2)) * 256 * 64;
    Vp = P.Vc + (size_t)(b * 2 + (hq >> 2)) * 64 * 256;
    nk = 256; vstride = 256;
  }
  char* sK = smem;
  char* sV = smem + 64 * 144;
  const int qrow = qrow0 + w * 32 + r;
  s16x8 Qf[4];
#pragma unroll
  for (int ks = 0; ks < 4; ++ks) Qf[ks] = *(const s16x8*)(P.Qb + (size_t)qrow * 512 + hq * 64 + ks * 16 + 8 * h);
  f32x16 O[2];
  O[0] = zero16();
  O[1] = zero16();
  float mrun = -1e30f, lrun = 0.f;
  const int NT = nk >> 6;
  const int lrow = tid >> 3, lkc = tid & 7;
  u32x4 rk[2], rv[2];
#pragma unroll
  for (int i = 0; i < 2; ++i) {
    rk[i] = *(const u32x4*)(Kp + (size_t)(lrow + 32 * i) * 64 + lkc * 8);
    rv[i] = *(const u32x4*)(Vp + (size_t)(lrow + 32 * i) * vstride + lkc * 8);
  }
  for (int kt = 0; kt < NT; ++kt) {
#pragma unroll
    for (int i = 0; i < 2; ++i) {
      *(u32x4*)(sK + (lrow + 32 * i) * 144 + lkc * 16) = rk[i];
      *(u32x4*)(sV + (lrow + 32 * i) * 144 + lkc * 16) = rv[i];
    }
    __syncthreads();
    if (kt + 1 < NT) {
#pragma unroll
      for (int i = 0; i < 2; ++i) {
        rk[i] = *(const u32x4*)(Kp + (size_t)((kt + 1) * 64 + lrow + 32 * i) * 64 + lkc * 8);
        rv[i] = *(const u32x4*)(Vp + (size_t)(lrow + 32 * i) * vstride + (kt + 1) * 64 + lkc * 8);
      }
    }
    f32x16 ST[2];
    float mx = -1e30f;
#pragma unroll
    for (int jt = 0; jt < 2; ++jt) {
      ST[jt] = zero16();
#pragma unroll
      for (int ks = 0; ks < 4; ++ks) {
        s16x8 A = *(const s16x8*)(sK + (32 * jt + r) * 144 + ks * 32 + h * 16);
        ST[jt] = mfma(A, Qf[ks], ST[jt]);
      }
#pragma unroll
      for (int reg = 0; reg < 16; ++reg) mx = fmaxf(mx, ST[jt][reg]);
    }
    mx = fmaxf(mx, __shfl_xor(mx, 32));
    const float mnew = fmaxf(mrun, mx);
    const float alpha = __builtin_amdgcn_exp2f(mrun - mnew);
    float lsum = 0.f;
#pragma unroll
    for (int jt = 0; jt < 2; ++jt)
#pragma unroll
      for (int reg = 0; reg < 16; ++reg) {
        float p = __builtin_amdgcn_exp2f(ST[jt][reg] - mnew);
        ST[jt][reg] = p;
        lsum += p;
      }
    lrun = lrun * alpha + lsum;
    const bool grew = mnew > mrun;
    mrun = mnew;
    if (__any(grew)) {
#pragma unroll
      for (int et = 0; et < 2; ++et)
#pragma unroll
        for (int reg = 0; reg < 16; ++reg) O[et][reg] *= alpha;
    }
#pragma unroll
    for (int jt = 0; jt < 2; ++jt)
#pragma unroll
      for (int s = 0; s < 2; ++s) {
        s16x8 Bp = pack8(ST[jt], s);
#pragma unroll
        for (int et = 0; et < 2; ++et) {
          s16x8 A = ldperm((const u16*)(sV + (32 * et + r) * 144) + 32 * jt + 16 * s, h);
          O[et] = mfma(A, Bp, O[et]);
        }
      }
    __syncthreads();
  }
  lrun += __shfl_xor(lrun, 32);
  const float inv = 1.f / lrun;
  u16* dst = P.H + (size_t)qrow * 1024 + 512 + hq * 64 + 4 * h;
#pragma unroll
  for (int et = 0; et < 2; ++et)
#pragma unroll
    for (int g = 0; g < 4; ++g) {
      u32x2 o = {pk2(O[et][4 * g] * inv, O[et][4 * g + 1] * inv), pk2(O[et][4 * g + 2] * inv, O[et][4 * g + 3] * inv)};
      *(u32x2*)(dst + 32 * et + 8 * g) = o;
    }
}

DI void mixer_phase(const Params& P, int l, char* smem, int cidx) {
  __shared__ int s_item;
  {
    const int b = blockIdx.x;
    if (b < 160) {
      const bool lat = b < 32;
      const int q = lat ? (b & 15) : ((b - 32) & 63);
      const bool is_m = lat ? (b < 16) : (b < 96);
      const int seq = lat ? 16 + (q >> 2) : (q >> 2);
      if (is_m) mstate_item(P, l, seq, q & 3);
      else dstate_item(P, l, seq, q & 3);
    }
  }
  const int total = 768;
  unsigned* ctr = P.ctr + cidx;
  while (true) {
    if (tidx() == 0) s_item = (int)atomicAdd(ctr, 1u);
    __syncthreads();
    const int item = s_item;
    __syncthreads();
    if (item >= total + (l == 0 ? LAYER_INIT_ITEMS : 0)) break;
    if (item >= total) { layer_init_item(P, 1, item - total, (float*)smem); continue; }
    if (item < 512) attn_item(P, true, item, smem);
    else attn_item(P, false, item - 512, smem);
    __syncthreads();
  }
}


#define XB_TMO 128
#define XB_XCNT(j) (256 + 64 * (j))
#define XB_XSUB(j) (1280 + 64 * (j))
#define XB_XGEN(j) (2304 + 64 * (j))
#define XB_TOP 3328
#define XB_TOPGEN 3392
#define XCD_BAR_WORDS 3456
#define XB_SPIN_CAP (1u << 20)
DI unsigned xb_ld(unsigned* p) { return __hip_atomic_load(p, __ATOMIC_RELAXED, __HIP_MEMORY_SCOPE_AGENT); }
DI unsigned xb_add(unsigned* p, unsigned v) { return __hip_atomic_fetch_add(p, v, __ATOMIC_RELAXED, __HIP_MEMORY_SCOPE_AGENT); }
DI unsigned xb_xcc_id() { return (unsigned)__builtin_amdgcn_s_getreg((3 << 11) | 20) & 0xFu; }
#define XB_SPIN(cond, bar)                                                         \
  do {                                                                             \
    unsigned _sp = 0;                                                              \
    while (cond) {                                                                 \
      __builtin_amdgcn_s_sleep(1);                                                 \
      if ((++_sp & 255u) == 0u) {                                                  \
        if (xb_ld(&(bar)[XB_TMO])) break;                                          \
        if (_sp > XB_SPIN_CAP) { atomicAdd(&(bar)[XB_TMO], 1u); break; }           \
      }                                                                            \
    }                                                                              \
  } while (0)

DI void xcd_barrier_complete(unsigned* bar, unsigned x, unsigned& nloc, unsigned& nx) {
  const unsigned G = gridDim.x;
  unsigned sum, cnt, mine, sp = 0u;
  for (;;) {
    sum = 0u; cnt = 0u; mine = 0u;
#pragma unroll
    for (unsigned j = 0; j < 16; ++j) {
      const unsigned c = xb_ld(&bar[XB_XCNT(j)]);
      sum += c;
      cnt += (c > 0u) ? 1u : 0u;
      mine = (j == x) ? c : mine;
    }
    if (sum == G) break;
    __builtin_amdgcn_s_sleep(1);
    if ((++sp & 255u) == 0u) {
      if (xb_ld(&bar[XB_TMO])) break;
      if (sp > XB_SPIN_CAP) { atomicAdd(&bar[XB_TMO], 1u); break; }
    }
  }
  nloc = mine > 0u ? mine : 1u;
  nx = cnt > 0u ? cnt : 1u;
}

DI void xcd_barrier(unsigned* bar, unsigned x, volatile unsigned* st) {
  asm volatile("s_waitcnt vmcnt(0)" ::: "memory");
  __syncthreads();
  if (__builtin_amdgcn_workitem_id_x() == 0) {
    __builtin_amdgcn_s_waitcnt(0);
    unsigned nloc = st[0], nx = st[1];
    if (nloc == 0u) { xcd_barrier_complete(bar, x, nloc, nx); st[0] = nloc; st[1] = nx; }
    const unsigned old = xb_add(&bar[XB_XSUB(x)], 1u);
    const unsigned gen = old / nloc;
    if (old + 1u == (gen + 1u) * nloc) {
      __builtin_amdgcn_fence(__ATOMIC_RELEASE, "agent");
      asm volatile("s_waitcnt vmcnt(0)" ::: "memory");
      const unsigned og = xb_add(&bar[XB_TOP], 1u);
      const unsigned tg = og / nx;
      if (og + 1u == (tg + 1u) * nx) xb_add(&bar[XB_TOPGEN], 1u);
      else XB_SPIN(xb_ld(&bar[XB_TOPGEN]) == tg, bar);
      __builtin_amdgcn_fence(__ATOMIC_ACQUIRE, "agent");
      xb_add(&bar[XB_XGEN(x)], 1u);
      asm volatile("s_waitcnt vmcnt(0)" ::: "memory");
    } else {
      XB_SPIN(xb_ld(&bar[XB_XGEN(x)]) == gen, bar);
      __builtin_amdgcn_fence(__ATOMIC_ACQUIRE, "agent");
      asm volatile("s_waitcnt vmcnt(0)" ::: "memory");
    }
  }
  __syncthreads();
}

DI void run_phase(const Params& P, int ph, char* smem, bool rep = false) {
  if (ph == 0) { init_phase(P, smem); return; }
  if (ph == NPHASE - 1) { final_norm_phase(P); return; }
  const int l = (ph - 1) / 12, s = (ph - 1) % 12;
  switch (s) {
    case 0: norm_phase(P, l, 0, l == 0); break;
    case 1: gemm_phase_e1(P.H, P.wt_ffn_in + (size_t)(l * 2 + 0) * 5632 * 1024, 1024, P, smem); break;
    case 2: gemm_phase_n4<2, 3>(P.R, P.wt_ffn_out + (size_t)(l * 2 + 0) * 1024 * 2816, 2816, 8, P, l, 2, rep ? 0.f : 0.5f, smem); break;
    case 3: norm_phase(P, l, 1, false); break;
    case 4: gemm_phase_n4<3, 3>(P.H, P.wt_win + (size_t)l * NWIN * 1024, 1024, 23, P, l, 0, 0.f, smem); break;
    case 5: prep_phase(P, l, smem); break;
    case 6: mixer_phase(P, l, smem, rep ? 2 + l : l); break;
    case 7: output_phase(P, l, smem); break;
    case 8: gemm_phase_n4<2, 3>(P.H, P.wt_wout + (size_t)l * 1024 * 1024, 1024, 8, P, l, 5, rep ? 0.f : 1.0f, smem); break;
    case 9: norm_phase(P, l, 2, false); break;
    case 10: gemm_phase_e1(P.H, P.wt_ffn_in + (size_t)(l * 2 + 1) * 5632 * 1024, 1024, P, smem); break;
    case 11: gemm_phase_n4<2, 3>(P.R, P.wt_ffn_out + (size_t)(l * 2 + 1) * 1024 * 2816, 2816, 8, P, l, 8, rep ? 0.f : 0.5f, smem); break;
  }
}

__global__ void __launch_bounds__(256, 2) mega_kernel(Params P) {
  __shared__ __attribute__((aligned(16))) char smem[SMEM_BYTES];
  __shared__ __attribute__((aligned(16))) unsigned xb_words[4];
  cg::grid_group grid = cg::this_grid();
  if (P.hi < 0) grid.sync();
  if (__builtin_amdgcn_workitem_id_x() == 0) { xb_words[0] = 0u; xb_words[1] = 0u; xb_words[2] = 0u; xb_words[3] = 0u; }
  __syncthreads();
  const unsigned xcc = xb_xcc_id();
  unsigned* bar = P.ctr + 64;
  if (__builtin_amdgcn_workitem_id_x() == 0) (void)xb_add(&bar[XB_XCNT(xcc)], 1u);
  for (int ph = P.lo; ph < P.hi; ++ph) {
    run_phase(P, ph, smem);
#ifdef PROBE_SET
    {
      const int sI = (ph - 1) % 12;
      bool rp = false;
      if (ph > 0 && ph < NPHASE - 1) {
        if (PROBE_SET == 1) rp = (sI == 1 || sI == 2 || sI == 4 || sI == 8 || sI == 10 || sI == 11);
        if (PROBE_SET == 2) rp = (sI == 5 || sI == 6 || sI == 7);
        if (PROBE_SET == 3) rp = (sI == 0 || sI == 3 || sI == 9);
        if (PROBE_SET == 4) rp = (sI == 5);
        if (PROBE_SET == 5) rp = (sI == 6);
        if (PROBE_SET == 6) rp = (sI == 7);
      }
      if (PROBE_SET == 3 && (ph == 0 || ph == NPHASE - 1)) rp = true;
      if (rp) { xcd_barrier(bar, xcc, xb_words); run_phase(P, ph, smem, true); }
    }
#endif
    if (ph + 1 < P.hi) xcd_barrier(bar, xcc, xb_words);
  }
}

extern "C" void kernel_launch(void* const* d_in, const int* in_sizes, int n_in, void* d_out, int out_size, void* d_ws, size_t ws_size,
                              hipStream_t stream) {
  Params P;
  memset(&P, 0, sizeof(P));
  const float* const* in = (const float* const*)d_in;
  P.xp = in[0]; P.xs = in[1]; P.c = in[2]; P.cache_k = in[3]; P.cache_v = in[4]; P.stC = in[5]; P.stn = in[6]; P.stm = in[7];
  P.stS = in[8]; P.c_ctx = in[9]; P.ada_w = in[10]; P.ada_b = in[11]; P.norm_g = in[12]; P.ffn_w_in = in[13]; P.ffn_w_out = in[14];
  P.w_in = in[15]; P.w_out = in[16]; P.fbias = in[17]; P.mnorm = in[18]; P.dconv = in[19]; P.alog = in[20]; P.dtb = in[21];
  P.dnorm = in[22]; P.qnorm = in[23]; P.knorm = in[24]; P.fnorm = in[25];
  P.out = (float*)d_out;
  char* ws = (char*)d_ws;
  size_t off = 0;
  auto take = [&](size_t bytes) { char* p = ws + off; off += (bytes + 255) & ~(size_t)255; return p; };
  P.ctr = (unsigned*)take(256 + XCD_BAR_WORDS * 4);
  P.wt_ffn_in = (u16*)take((size_t)4 * 5632 * 1024 * 2);
  P.wt_ffn_out = (u16*)take((size_t)4 * 1024 * 2816 * 2);
  P.wt_win = (u16*)take((size_t)2 * NWIN * 1024 * 2);
  P.wt_wout = (u16*)take((size_t)2 * 1024 * 1024 * 2);
  P.X = (u16*)take((size_t)NTOK * 1024 * 2);
  P.H = (u16*)take((size_t)NTOK * 1024 * 2);
  P.R = (u16*)take((size_t)NTOK * 2816 * 2);
  P.Zg = (float*)take((size_t)NTOK * 32 * 4);
  P.mod = (float*)take((size_t)2 * 5 * 9216 * 4);
  P.rope = (float*)take(64 * 16 * 2 * 4);
  P.KTm = (u16*)take((size_t)768 * 4096 * 2);
  P.VTm = (u16*)take((size_t)768 * 4096 * 2);
  P.dprep = (u16*)take((size_t)1536 * 20480 * 2);
  P.dgl = (float*)take(1536 * 4);
  P.Ubuf = (u16*)take((size_t)3072 * 2048 * 2);
  P.Cst = (u16*)take((size_t)3072 * 2048 * 2);
  P.Sst = (u16*)take((size_t)3072 * 2048 * 2);
  P.mg_a = (float*)take((size_t)2 * NTOK * 4 * 4);
  P.mg_b = (float*)take((size_t)2 * NTOK * 4 * 4);
  P.mg_cm = (float*)take((size_t)2 * NTOK * 4 * 4);
  P.mchunk = (float*)take((size_t)1536 * 2 * 4);
  P.nUbuf = (float*)take((size_t)1536 * 64 * 4);
  P.nst = (float*)take((size_t)1536 * 64 * 4);
  P.mst = (float*)take((size_t)1536 * 4);
  P.Qb = (u16*)take((size_t)NTOK * 512 * 2);
  P.Kc = (u16*)take((size_t)16 * 2 * 256 * 64 * 2);
  P.Vc = (u16*)take((size_t)16 * 2 * 256 * 64 * 2);
  P.Kl = (u16*)take((size_t)4 * 2 * 2560 * 64 * 2);
  P.Vl = (u16*)take((size_t)4 * 2 * 2560 * 64 * 2);
  if (off > ws_size) { fprintf(stderr, "workspace too small: need %zu have %zu\n", off, ws_size); return; }

  static int grid_blocks = 0;
  if (!grid_blocks) {
    int dev = 0, cus = 0, per_cu = 0;
    (void)hipGetDevice(&dev);
    (void)hipDeviceGetAttribute(&cus, hipDeviceAttributeMultiprocessorCount, dev);
    (void)hipOccupancyMaxActiveBlocksPerMultiprocessor(&per_cu, mega_kernel, 256, 0);
    if (per_cu > 2) per_cu = 2;
    if (per_cu < 1) per_cu = 1;
    grid_blocks = cus * per_cu;
  }
  (void)hipMemsetAsync(P.ctr, 0, 256 + XCD_BAR_WORDS * 4, stream);
#if MULTI_LAUNCH
  for (int ph = 0; ph < NPHASE; ++ph) {
    P.lo = ph; P.hi = ph + 1;
    hipLaunchKernelGGL(mega_kernel, dim3(grid_blocks), dim3(256), 0, stream, P);
  }
#else
  P.lo = 0; P.hi = NPHASE;
  void* args[] = {&P};
  hipError_t e = hipLaunchCooperativeKernel((void*)mega_kernel, dim3(grid_blocks), dim3(256), args, 0, stream);
  if (e != hipSuccess) fprintf(stderr, "cooperative launch failed: %s (grid %d)\n", hipGetErrorString(e), grid_blocks);
#endif
}
```
